# Optimizing an MI355X kernel written in HIP

```python
import math
import jax, jax.numpy as jnp
from jax import lax
import numpy as np

D_MODEL = 2048
BATCH = 4
SEQ = 4096
DEPTH = 1

N_META = 16
D_CONV = 2048
CONV_K = 3
D_POOL = 1024
POOL_WINDOWS = (2, 4, 8, 16)
N_POOL_GROUPS = len(POOL_WINDOWS)
POOL_GROUP_IN = D_POOL // N_POOL_GROUPS
POOL_GROUP_OUT = D_MODEL // N_POOL_GROUPS
N_BRANCH = 2
D_IN_PROJ = 3 * D_CONV + D_POOL + N_BRANCH * D_MODEL
N_EXPERTS = 32
TOP_K = 4
D_EXPERT = 2048
SWIGLU_LIMIT = 7.0
SWIGLU_ALPHA = 1.702
LN_EPS = 1e-5
DEEPNORM_ALPHA = (2.0 * DEPTH) ** 0.25
DEEPNORM_BETA = (8.0 * DEPTH) ** -0.25

kernel_name = "hybrid_conv_pool_moe_deepnorm_layer"


def layer_norm(x, g, b):
    xf = x.astype(jnp.float32)
    mu = jnp.mean(xf, axis=-1, keepdims=True)
    var = jnp.mean(jnp.square(xf - mu), axis=-1, keepdims=True)
    y = (xf - mu) * lax.rsqrt(var + LN_EPS) * g.astype(jnp.float32) + b.astype(jnp.float32)
    return y.astype(x.dtype)


def causal_short_conv(z, w):
    L = z.shape[1]
    zp = jnp.pad(z, ((0, 0), (CONV_K - 1, 0), (0, 0)))
    y = w[0] * zp[:, 0:L]
    for k in range(1, CONV_K):
        y = y + w[k] * zp[:, k:k + L]
    return y


def multiscale_pool(v, pool_w, pool_scale):
    B, L, _ = v.shape
    vf = v.astype(jnp.float32).reshape(B, L, N_POOL_GROUPS, POOL_GROUP_IN)
    cs = jnp.concatenate([jnp.zeros_like(vf[:, :1]), jnp.cumsum(vf, axis=1)], axis=1)
    t = jnp.arange(L, dtype=jnp.int32)[:, None]
    win = jnp.asarray(POOL_WINDOWS, dtype=jnp.int32)[None, :]
    lo = jnp.maximum(t + 1 - win, 0)
    cs_lo = cs[:, lo, jnp.arange(N_POOL_GROUPS)[None, :], :]
    count = (t + 1 - lo).astype(jnp.float32)
    pooled = (cs[:, 1:] - cs_lo) / count[None, :, :, None] - vf
    pooled = pooled.astype(v.dtype)
    y = jnp.einsum('blgc,gcd->blgd', pooled, pool_w)
    return y.reshape(B, L, D_MODEL) * pool_scale


def token_mixer(h, w_in, conv_w, w_a_out, pool_w, pool_scale, w_o):
    proj = jnp.einsum('bld,de->ble', h, w_in)
    b_gate, c_gate, u, v, gates = jnp.split(
        proj, [D_CONV, 2 * D_CONV, 3 * D_CONV, 3 * D_CONV + D_POOL], axis=-1)
    y_a = jnp.einsum('blc,cd->bld', b_gate * causal_short_conv(c_gate * u, conv_w), w_a_out)
    y_b = multiscale_pool(v, pool_w, pool_scale)
    g = jax.nn.sigmoid(gates)
    merged = g[..., :D_MODEL] * y_a + g[..., D_MODEL:] * y_b
    return jnp.einsum('bld,de->ble', merged, w_o)


def moe(h, router_w, router_b, w_gate_up, b_gate_up, w_down, b_down):
    B, L, D = h.shape
    tok = h.reshape(B * L, D)
    logits = (tok @ router_w + router_b).astype(jnp.float32)
    top_v, top_i = lax.top_k(logits, TOP_K)
    wts = jax.nn.softmax(top_v, axis=-1)
    flat_e = top_i.reshape(-1)
    order = jnp.argsort(flat_e)
    e_sorted = flat_e[order]
    tok_idx = order // TOP_K
    xs = tok[tok_idx]
    group_sizes = jnp.bincount(flat_e, length=N_EXPERTS).astype(jnp.int32)
    gu = lax.ragged_dot(xs, w_gate_up, group_sizes) + b_gate_up[e_sorted]
    gate = jnp.minimum(gu[:, :D_EXPERT], SWIGLU_LIMIT)
    lin = jnp.clip(gu[:, D_EXPERT:], -SWIGLU_LIMIT, SWIGLU_LIMIT)
    act = (lin + 1.0) * gate * jax.nn.sigmoid(SWIGLU_ALPHA * gate)
    out = lax.ragged_dot(act, w_down, group_sizes) + b_down[e_sorted]
    out = out * wts.reshape(-1)[order][:, None].astype(out.dtype)
    y = jnp.zeros_like(tok).at[tok_idx].add(out)
    return y.reshape(B, L, D)


def setup_inputs(seed: int = 0) -> dict:
    key = jax.random.key(seed)
    ks = jax.random.split(key, 20)
    nrm = lambda k, shape, s: jax.random.normal(k, shape, jnp.float32) * s
    Lyr = DEPTH
    return {
        "x": nrm(ks[0], (BATCH, SEQ, D_MODEL), 1.0),
        "meta_tokens": nrm(ks[1], (N_META, D_MODEL), 1.0),
        "ln_in_g": 1.0 + nrm(ks[2], (D_MODEL,), 0.02),
        "ln_in_b": nrm(ks[3], (D_MODEL,), 0.02),
        "w_in": nrm(ks[4], (Lyr, D_MODEL, D_IN_PROJ), D_MODEL ** -0.5),
        "conv_w": nrm(ks[5], (Lyr, CONV_K, D_CONV), CONV_K ** -0.5),
        "w_a_out": nrm(ks[6], (Lyr, D_CONV, D_MODEL), D_CONV ** -0.5 * DEEPNORM_BETA),
        "pool_w": nrm(ks[7], (Lyr, N_POOL_GROUPS, POOL_GROUP_IN, POOL_GROUP_OUT), POOL_GROUP_IN ** -0.5 * DEEPNORM_BETA),
        "pool_scale": 1.0 + nrm(ks[8], (Lyr, D_MODEL), 0.02),
        "w_o": nrm(ks[9], (Lyr, D_MODEL, D_MODEL), D_MODEL ** -0.5 * DEEPNORM_BETA),
        "ln1_g": 1.0 + nrm(ks[10], (Lyr, D_MODEL), 0.02),
        "ln1_b": nrm(ks[11], (Lyr, D_MODEL), 0.02),
        "router_w": nrm(ks[12], (Lyr, D_MODEL, N_EXPERTS), D_MODEL ** -0.5),
        "router_b": nrm(ks[13], (Lyr, N_EXPERTS), 0.01),
        "w_gate_up": nrm(ks[14], (Lyr, N_EXPERTS, D_MODEL, 2 * D_EXPERT), D_MODEL ** -0.5),
        "b_gate_up": nrm(ks[15], (Lyr, N_EXPERTS, 2 * D_EXPERT), 0.02),
        "w_down": nrm(ks[16], (Lyr, N_EXPERTS, D_EXPERT, D_MODEL), D_EXPERT ** -0.5 * DEEPNORM_BETA),
        "b_down": nrm(ks[17], (Lyr, N_EXPERTS, D_MODEL), 0.02),
        "ln2_g": 1.0 + nrm(ks[18], (Lyr, D_MODEL), 0.02),
        "ln2_b": nrm(ks[19], (Lyr, D_MODEL), 0.02),
    }


def reference(x, meta_tokens, ln_in_g, ln_in_b, w_in, conv_w, w_a_out, pool_w, pool_scale, w_o,
              ln1_g, ln1_b, router_w, router_b, w_gate_up, b_gate_up, w_down, b_down, ln2_g, ln2_b):
    B = x.shape[0]
    meta = jnp.broadcast_to(meta_tokens[None].astype(x.dtype), (B, N_META, D_MODEL))
    h = jnp.concatenate([meta, x], axis=1)
    h = layer_norm(h, ln_in_g, ln_in_b)
    for i in range(DEPTH):
        mix = token_mixer(h, w_in[i], conv_w[i], w_a_out[i], pool_w[i], pool_scale[i], w_o[i])
        h = layer_norm(DEEPNORM_ALPHA * h + mix, ln1_g[i], ln1_b[i])
        ffn = moe(h, router_w[i], router_b[i], w_gate_up[i], b_gate_up[i], w_down[i], b_down[i])
        h = layer_norm(DEEPNORM_ALPHA * h + ffn, ln2_g[i], ln2_b[i])
    return h[:, N_META:]
```

```cpp
#include <hip/hip_runtime.h>
#include <cstdio>
#include <cstdint>

#ifndef MK_N_LAUNCHES
#define MK_N_LAUNCHES 1
#endif

#ifndef MK_P1_KREP
#define MK_P1_KREP 1
#endif
#ifndef MK_P4_KREP
#define MK_P4_KREP 1
#endif
#ifndef MK_P6_EPIREP
#define MK_P6_EPIREP 1
#endif
#ifndef MK_P7_EPIREP
#define MK_P7_EPIREP 1
#endif
#ifndef MK_ALIGN8
#define MK_ALIGN8 true
#endif
#ifndef MK_B_NT
#define MK_B_NT false
#endif
#ifndef MK_P6_KREP
#define MK_P6_KREP 1
#endif
#ifndef MK_P1_EPIREP
#define MK_P1_EPIREP 1
#endif
#define GAS __attribute__((address_space(1)))
#define LAS __attribute__((address_space(3)))
typedef unsigned short bf16_t;
typedef short bf16x8 __attribute__((ext_vector_type(8)));
typedef float f32x4 __attribute__((ext_vector_type(4)));
typedef float f32x2 __attribute__((ext_vector_type(2)));
typedef unsigned u32x4 __attribute__((ext_vector_type(4)));
typedef unsigned u32x2 __attribute__((ext_vector_type(2)));
typedef int i32x4v __attribute__((ext_vector_type(4)));
typedef int i32x8v __attribute__((ext_vector_type(8)));

constexpr int NB = 4, SEQ = 4096, D = 2048, T = NB * SEQ, NMETA = 16;
constexpr int DIN = 11264, NE = 32, TOPK = 4;
constexpr float LN_EPS = 1e-5f, SW_LIMIT = 7.0f, SW_ALPHA = 1.702f, DN_ALPHA = 1.189207115002721f;
constexpr int NPHASE = 9;
constexpr int NWAVES = 8, NTHREADS = 512;
constexpr int MAXTILES = 288;
constexpr int APITCH = 3072;

constexpr size_t MiB = (size_t)1 << 20;
constexpr size_t WS_CTL = 0, CTL_ZERO_BYTES = 64 * 1024;
constexpr size_t WS_WIN_T = 2 * MiB;
constexpr size_t WS_WA_T = 46 * MiB;
constexpr size_t WS_WO_T = 54 * MiB;
constexpr size_t WS_WP_T = 62 * MiB;
constexpr size_t WS_RW = 70 * MiB;
constexpr size_t WS_META = 71 * MiB;
constexpr size_t WS_WGU_T = 72 * MiB;
constexpr size_t WS_WD_T = 584 * MiB;
constexpr size_t WS_H1Q = 712 * MiB;
constexpr size_t WS_H0Q = 744 * MiB;
constexpr size_t WS_WIN8 = 776 * MiB;
constexpr size_t WS_H0 = 840 * MiB;
constexpr size_t WS_BG = 904 * MiB;
constexpr size_t WS_CU = 968 * MiB;
constexpr size_t WS_V = 1032 * MiB;
constexpr size_t WS_G = 1064 * MiB;
constexpr size_t WS_AP = 1192 * MiB;
constexpr size_t WS_YB = 1288 * MiB;
constexpr size_t WS_MERGED = 1352 * MiB;
constexpr size_t WS_Z = 1416 * MiB;
constexpr size_t WS_H1 = 1544 * MiB;
constexpr size_t WS_ROUTE = 1608 * MiB;
constexpr size_t WS_ACT = 1616 * MiB;
constexpr size_t WS_OSLOT = 1904 * MiB;
constexpr size_t WS_END = 2192 * MiB;
constexpr int CW_TMO = 0, CW_CNT = 64, CW_GDONE = 256, CW_CONV = 1024, CW_BAR = 4096;
constexpr float P4_M_SCALE = 16.f, P4_WO_SCALE = 512.f;
constexpr float P3_A_SCALE = 8.f, P3_WA_SCALE = 512.f, P3_WP_SCALE = 128.f;
constexpr float W_SCALE_GU = 256.f, W_SCALE_D = 512.f, H1_SCALE = 16.f, ACT_SCALE = 4.f, H0_SCALE = 16.f, W_SCALE_IN = 256.f, OS_SCALE = 32.f;
constexpr float Q_ACT_SIGMAS = 5.0f, Q_W_SIGMAS = 5.5f;
#ifndef MK_ALL_FP8
#define MK_CONV_N 1
#define MK_CONVWRAP 0
#define MK_CONVMASK 0x1a
#define MK_CONVPROBE 0
#define MK_GG1 208
#define MK_GG3 176
#define MK_GG4 176
#define MK_ALL_FP8 1
#endif
constexpr int NT_BF = MK_ALL_FP8 ? 0 : 12;

constexpr int LDS_BYTES = 159744;
constexpr int L_STAGE = 0;
constexpr int L_ROWS = 131072;
constexpr int L_TILE_E = L_ROWS + 18 * 1024;
constexpr int L_CNT = L_TILE_E + MAXTILES * 4;
constexpr int L_TBASE = L_CNT + 128;
constexpr int L_MISC = 155648;
constexpr int L_QS = L_MISC + 128;
constexpr int RPITCH = 4112;
constexpr int L_AHI = 0, L_ALO = 16 * RPITCH, L_PART = 2 * 16 * RPITCH;
constexpr int L_SEL_E = L_PART + 16384, L_SEL_R = L_SEL_E + 1024, L_SEL_W = L_SEL_R + 1024, L_HIST = L_SEL_W + 1024, L_BASE = L_HIST + 128;
static_assert(L_BASE + 128 <= L_MISC && L_TBASE + 256 <= L_MISC && L_QS + 256 <= LDS_BYTES, "LDS map");

#define RLX_AGENT __ATOMIC_RELAXED, __HIP_MEMORY_SCOPE_AGENT
#define LDS_WAIT() asm volatile("s_waitcnt lgkmcnt(0)" ::: "memory")
#define VM_WAIT() asm volatile("s_waitcnt vmcnt(0)" ::: "memory")

__device__ __forceinline__ unsigned cvt_pk_bf16(float lo, float hi) { unsigned r; asm volatile("v_cvt_pk_bf16_f32 %0, %1, %2" : "=v"(r) : "v"(lo), "v"(hi)); return r; }
__device__ __forceinline__ float bf_lo(unsigned w) { return __uint_as_float(w << 16); }
__device__ __forceinline__ float bf_hi(unsigned w) { return __uint_as_float(w & 0xffff0000u); }
__device__ __forceinline__ u32x4 pack8(const f32x4 a, const f32x4 b) { u32x4 w; w.x = cvt_pk_bf16(a[0], a[1]); w.y = cvt_pk_bf16(a[2], a[3]); w.z = cvt_pk_bf16(b[0], b[1]); w.w = cvt_pk_bf16(b[2], b[3]); return w; }
__device__ __forceinline__ void unpack8(const u32x4 w, f32x4& a, f32x4& b) { a = (f32x4){bf_lo(w.x), bf_hi(w.x), bf_lo(w.y), bf_hi(w.y)}; b = (f32x4){bf_lo(w.z), bf_hi(w.z), bf_lo(w.w), bf_hi(w.w)}; }
__device__ __forceinline__ float clamp448(float x) { return __builtin_fminf(__builtin_fmaxf(x, -448.f), 448.f); }
__device__ __forceinline__ unsigned pack4_fp8(float a, float b, float c, float d) { int r = 0; r = __builtin_amdgcn_cvt_pk_fp8_f32(a, b, r, false); r = __builtin_amdgcn_cvt_pk_fp8_f32(c, d, r, true); return (unsigned)r; }
__device__ __forceinline__ unsigned pack4_i8(float a, float b, float c, float d) {
    unsigned r = 0;
    r = __builtin_amdgcn_cvt_pk_u8_f32(__builtin_amdgcn_fmed3f(__builtin_rintf(a) + 128.0f, 1.0f, 255.0f), 0, r); r = __builtin_amdgcn_cvt_pk_u8_f32(__builtin_amdgcn_fmed3f(__builtin_rintf(b) + 128.0f, 1.0f, 255.0f), 1, r);
    r = __builtin_amdgcn_cvt_pk_u8_f32(__builtin_amdgcn_fmed3f(__builtin_rintf(c) + 128.0f, 1.0f, 255.0f), 2, r); r = __builtin_amdgcn_cvt_pk_u8_f32(__builtin_amdgcn_fmed3f(__builtin_rintf(d) + 128.0f, 1.0f, 255.0f), 3, r);
    return r ^ 0x80808080u;
}
__device__ __forceinline__ unsigned pack4_u8(float a, float b, float c, float d) {
    unsigned r = 0;
    r = __builtin_amdgcn_cvt_pk_u8_f32(__builtin_amdgcn_fmed3f(__builtin_rintf(a), 1.0f, 255.0f), 0, r); r = __builtin_amdgcn_cvt_pk_u8_f32(__builtin_amdgcn_fmed3f(__builtin_rintf(b), 1.0f, 255.0f), 1, r);
    r = __builtin_amdgcn_cvt_pk_u8_f32(__builtin_amdgcn_fmed3f(__builtin_rintf(c), 1.0f, 255.0f), 2, r); r = __builtin_amdgcn_cvt_pk_u8_f32(__builtin_amdgcn_fmed3f(__builtin_rintf(d), 1.0f, 255.0f), 3, r);
    return r;
}
__device__ __forceinline__ f32x4 u8x4_to_f(unsigned w) { return (f32x4){(float)(w & 0xffu), (float)((w >> 8) & 0xffu), (float)((w >> 16) & 0xffu), (float)(w >> 24)}; }
__device__ __forceinline__ f32x4 s8x4_to_f(unsigned w) { const int i = (int)w; return (f32x4){(float)((i << 24) >> 24), (float)((i << 16) >> 24), (float)((i << 8) >> 24), (float)(i >> 24)}; }
__device__ __forceinline__ f32x4 i2f(const f32x4 a) { const i32x4v i = __builtin_bit_cast(i32x4v, a); return (f32x4){(float)i[0], (float)i[1], (float)i[2], (float)i[3]}; }
__device__ __forceinline__ float sigmoidf_fast(float x) { return __builtin_amdgcn_rcpf(1.0f + __builtin_amdgcn_exp2f(-1.4426950408889634f * x)); }
template <int CTRL> __device__ __forceinline__ float dpp_mov(float v) { return __builtin_bit_cast(float, __builtin_amdgcn_update_dpp(__builtin_bit_cast(int, v), __builtin_bit_cast(int, v), CTRL, 0xF, 0xF, true)); }
__device__ __forceinline__ float wave_sum(float v) {
    v += dpp_mov<0xB1>(v); v += dpp_mov<0x4E>(v); v += dpp_mov<0x141>(v); v += dpp_mov<0x140>(v);
    const int x = __builtin_bit_cast(int, v);
    const float r0 = __builtin_bit_cast(float, __builtin_amdgcn_readlane(x, 0)), r1 = __builtin_bit_cast(float, __builtin_amdgcn_readlane(x, 16)),
                r2 = __builtin_bit_cast(float, __builtin_amdgcn_readlane(x, 32)), r3 = __builtin_bit_cast(float, __builtin_amdgcn_readlane(x, 48));
    return (r0 + r1) + (r2 + r3);
}
__device__ __forceinline__ float wave_max(float v) {
    v = fmaxf(v, dpp_mov<0xB1>(v)); v = fmaxf(v, dpp_mov<0x4E>(v)); v = fmaxf(v, dpp_mov<0x141>(v)); v = fmaxf(v, dpp_mov<0x140>(v));
    const int x = __builtin_bit_cast(int, v);
    const float r0 = __builtin_bit_cast(float, __builtin_amdgcn_readlane(x, 0)), r1 = __builtin_bit_cast(float, __builtin_amdgcn_readlane(x, 16)),
                r2 = __builtin_bit_cast(float, __builtin_amdgcn_readlane(x, 32)), r3 = __builtin_bit_cast(float, __builtin_amdgcn_readlane(x, 48));
    return fmaxf(fmaxf(r0, r1), fmaxf(r2, r3));
}

#define XB_TMO      128
#define XB_XCNT(j)  (256  + 64 * (j))
#define XB_XSUB(j)  (1280 + 64 * (j))
#define XB_XGEN(j)  (2304 + 64 * (j))
#define XB_TOP      3328
#define XB_TOPGEN   3392
#define XCD_BAR_WORDS 3456
#define XB_SPIN_CAP (1u << 18)
__device__ __forceinline__ unsigned xb_ld(unsigned* p)              { return __hip_atomic_load(p, __ATOMIC_RELAXED, __HIP_MEMORY_SCOPE_AGENT); }
__device__ __forceinline__ unsigned xb_add(unsigned* p, unsigned v) { return __hip_atomic_fetch_add(p, v, __ATOMIC_RELAXED, __HIP_MEMORY_SCOPE_AGENT); }
__device__ __forceinline__ unsigned xb_xcc_id() { return (unsigned)__builtin_amdgcn_s_getreg((3 << 11) | 20) & 0xFu; }
#define XB_SPIN(cond, bar) do { unsigned _sp = 0; while (cond) { __builtin_amdgcn_s_sleep(1); \
    if ((++_sp & 255u) == 0u) { if (xb_ld(&(bar)[XB_TMO])) break; if (_sp > XB_SPIN_CAP) { atomicAdd(&(bar)[XB_TMO], 1u); break; } } } } while (0)
struct XcdBarrier { unsigned* bar; unsigned x; volatile LAS unsigned* st; };
__device__ __forceinline__ XcdBarrier xcd_barrier_post(unsigned* bar, volatile LAS unsigned* st) {
    XcdBarrier b; b.bar = bar; b.x = xb_xcc_id(); b.st = st;
    if (threadIdx.x == 0) (void)xb_add(&bar[XB_XCNT(b.x)], 1u);
    return b;
}
__device__ __forceinline__ void xcd_barrier_complete(unsigned* bar, unsigned x, unsigned& nloc, unsigned& nx) {
    const unsigned G = gridDim.x * gridDim.y * gridDim.z;
    unsigned sum, cnt, mine, sp = 0u;
    for (;;) {
        sum = 0u; cnt = 0u; mine = 0u;
#pragma unroll
        for (unsigned j = 0; j < 16; ++j) { const unsigned c = xb_ld(&bar[XB_XCNT(j)]); sum += c; cnt += (c > 0u) ? 1u : 0u; mine = (j == x) ? c : mine; }
        if (sum == G) break;
        __builtin_amdgcn_s_sleep(1);
        if ((++sp & 255u) == 0u) { if (xb_ld(&bar[XB_TMO])) break; if (sp > XB_SPIN_CAP) { atomicAdd(&bar[XB_TMO], 1u); break; } }
    }
    nloc = mine > 0u ? mine : 1u; nx = cnt > 0u ? cnt : 1u;
}
__device__ __forceinline__ void xcd_barrier(const XcdBarrier& b) {
    asm volatile("s_waitcnt vmcnt(0)" ::: "memory");
    __syncthreads();
    if (threadIdx.x == 0) {
        unsigned* bar = b.bar;
        __builtin_amdgcn_s_waitcnt(0);
        unsigned nloc = b.st[0], nx = b.st[1];
        if (nloc == 0u) { xcd_barrier_complete(bar, b.x, nloc, nx); b.st[0] = nloc; b.st[1] = nx; }
        const unsigned old = xb_add(&bar[XB_XSUB(b.x)], 1u);
        const unsigned gen = old / nloc;
        if (old + 1u == (gen + 1u) * nloc) {
            __builtin_amdgcn_fence(__ATOMIC_RELEASE, "agent");
            asm volatile("s_waitcnt vmcnt(0)" ::: "memory");
            const unsigned og = xb_add(&bar[XB_TOP], 1u);
            const unsigned tg = og / nx;
            if (og + 1u == (tg + 1u) * nx) xb_add(&bar[XB_TOPGEN], 1u);
            else XB_SPIN(xb_ld(&bar[XB_TOPGEN]) == tg, bar);
            __builtin_amdgcn_fence(__ATOMIC_ACQUIRE, "agent");
            xb_add(&bar[XB_XGEN(b.x)], 1u);
            asm volatile("s_waitcnt vmcnt(0)" ::: "memory");
        } else {
            XB_SPIN(xb_ld(&bar[XB_XGEN(b.x)]) == gen, bar);
            __builtin_amdgcn_fence(__ATOMIC_ACQUIRE, "agent");
            asm volatile("s_waitcnt vmcnt(0)" ::: "memory");
        }
    }
    __syncthreads();
}

namespace pg8 {
constexpr int BM = 256, BK = 64, HALF = 128, HTB = HALF * BK * 2, STAGE_BYTES = 8 * HTB, NXCD = 8, WGM = 8;
__host__ __device__ __forceinline__ int lds_byte(int r, int c) { const int st = (r >> 4) * 2 + (c >> 5), rr = r & 15, cc = c & 31, ob = rr * 64 + cc * 2; return st * 1024 + (ob ^ (((ob >> 9) & 1) << 5)); }
__host__ __device__ __forceinline__ void stage_rc(int b, int& R, int& C) { const int st = b / 1024, sb = b % 1024, swz = sb ^ (((sb >> 9) & 1) << 5); R = (st >> 1) * 16 + swz / 64; C = (st & 1) * 32 + (swz % 64) / 2; }
__host__ __device__ __forceinline__ int perm32(int rho) { const int n = rho >> 4, i = rho & 15; return 8 * (i >> 2) + 4 * n + (i & 3); }

__device__ __forceinline__ bool order_unit(int i, int G, int c, int nM, int nN, int& pm, int& pn) {
    const int nwg = nM * nN; const long L = (long)i * G + c; if (L >= nwg) return false;
    int wgid = (int)L; { const int q = nwg / NXCD, r = nwg % NXCD, xcd = wgid % NXCD, off = wgid / NXCD; wgid = (xcd < r ? xcd * (q + 1) : r * (q + 1) + (xcd - r) * q) + off; }
    const int nig = WGM * nN, gid = wgid / nig, fm = gid * WGM, gsz = (nM - fm) < WGM ? (nM - fm) : WGM;
    pm = fm + ((wgid % nig) % gsz); pn = (wgid % nig) / gsz; return true;
}

template <class P>
__device__ __forceinline__ void gemm_phase(LAS unsigned char* lds, const P& prob) {
    const int tid = threadIdx.x, wid = __builtin_amdgcn_readfirstlane(tid >> 6), lane = tid & 63, wr = wid >> 2, wc = wid & 3, fr = lane & 15, fq = lane >> 4;
    int R[2], C[2]; unsigned vB[2];
#pragma unroll
    for (int i = 0; i < 2; ++i) { stage_rc(tid * 16 + i * 8192, R[i], C[i]); const int Rb = (R[i] & ~31) + perm32(R[i] & 31); vB[i] = (unsigned)(Rb * P::LDB + C[i]) * 2u; }
    constexpr unsigned kstep = (unsigned)(BK * 2);
    constexpr unsigned hstepB = (unsigned)HALF * P::LDB * 2u;
    const unsigned ldsw = (unsigned)wid * 1024u;
    const int aoff = lds_byte(wr * 64 + fr, fq * 8), boff = lds_byte(wc * 32 + fr, fq * 8);
    const __amdgpu_buffer_rsrc_t rA = prob.a_rsrc(), rB = prob.b_rsrc();
#define PG8_SA(b, h) (((b) * 2 + (h)) * HTB)
#define PG8_SB(b, h) ((4 + (b) * 2 + (h)) * HTB)
#define PG8_STAGE(bufoff, rsrc, soff, voff) do { _Pragma("unroll") for (int _i = 0; _i < 2; ++_i) \
        __builtin_amdgcn_raw_ptr_buffer_load_lds(rsrc, (LAS void*)(lds + (bufoff) + ldsw + _i * 8192), 16, (int)(voff)[_i], (int)(soff), 0, 0); } while (0)
#define PG8_STAGE_B(bufoff, rsrc, soff, voff) do { _Pragma("unroll") for (int _i = 0; _i < 2; ++_i) \
        __builtin_amdgcn_raw_ptr_buffer_load_lds(rsrc, (LAS void*)(lds + (bufoff) + ldsw + _i * 8192), 16, (int)(voff)[_i], (int)(soff), 0, P::B_NT ? 2 : 0); } while (0)
#define PG8_LDA(dst, b, h) do { _Pragma("unroll") for (int m = 0; m < 4; ++m) _Pragma("unroll") for (int k = 0; k < 2; ++k) dst[m][k] = *(const LAS bf16x8*)(lds + PG8_SA(b, h) + aoff + m * 2048 + k * 1024); } while (0)
#define PG8_LDB(dst, b, h) do { _Pragma("unroll") for (int n = 0; n < 2; ++n) _Pragma("unroll") for (int k = 0; k < 2; ++k) dst[n][k] = *(const LAS bf16x8*)(lds + PG8_SB(b, h) + boff + n * 2048 + k * 1024); } while (0)
#define PG8_CAT(x) __builtin_shufflevector(__builtin_bit_cast(i32x4v, (x)[0]), __builtin_bit_cast(i32x4v, (x)[1]), 0, 1, 2, 3, 4, 5, 6, 7)
#define PG8_MMA(ai, bj, At, Bt) do { __builtin_amdgcn_s_setprio(1); \
        if constexpr (P::FP8) { _Pragma("unroll") for (int m = 0; m < 4; ++m) _Pragma("unroll") for (int n = 0; n < 2; ++n) \
            asm volatile("v_mfma_scale_f32_16x16x128_f8f6f4 %0, %1, %2, %0, %3, %3 op_sel_hi:[0,0,0]" : "+v"(acc[ai][bj][m][n]) : "v"(PG8_CAT(Bt[n])), "v"(PG8_CAT(At[m])), "v"(one_scale)); } \
        else if constexpr (P::I8) { _Pragma("unroll") for (int m = 0; m < 4; ++m) _Pragma("unroll") for (int n = 0; n < 2; ++n) _Pragma("unroll") for (int k = 0; k < 2; ++k) \
            acc[ai][bj][m][n] = __builtin_bit_cast(f32x4, __builtin_amdgcn_mfma_i32_16x16x64_i8(__builtin_bit_cast(i32x4v, Bt[n][k]), __builtin_bit_cast(i32x4v, At[m][k]), __builtin_bit_cast(i32x4v, acc[ai][bj][m][n]), 0, 0, 0)); } \
        else { _Pragma("unroll") for (int m = 0; m < 4; ++m) _Pragma("unroll") for (int n = 0; n < 2; ++n) _Pragma("unroll") for (int k = 0; k < 2; ++k) \
            acc[ai][bj][m][n] = __builtin_amdgcn_mfma_f32_16x16x32_bf16(Bt[n][k], At[m][k], acc[ai][bj][m][n], 0, 0, 0); } \
        __builtin_amdgcn_s_setprio(0); } while (0)
#define PG8_WAIT_V(n) asm volatile("s_waitcnt vmcnt(" #n ")" ::: "memory")
#define PG8_WAIT_L(n) asm volatile("s_waitcnt lgkmcnt(" #n ")" ::: "memory")
#define PG8_BAR __builtin_amdgcn_s_barrier()
#define PG8_SCHED __builtin_amdgcn_sched_barrier(0)
    typename P::U cur, nxt; int ui = 0;
    if (!prob.next(0, cur)) return;
    f32x4 acc[2][2][4][2];
#pragma unroll
    for (int a = 0; a < 2; ++a)
#pragma unroll
        for (int b = 0; b < 2; ++b)
#pragma unroll
            for (int m = 0; m < 4; ++m)
#pragma unroll
                for (int n = 0; n < 2; ++n) acc[a][b][m][n] = (f32x4){0.f, 0.f, 0.f, 0.f};
    bf16x8 At[4][2], B0[2][2], B1[2][2];
    unsigned one_scale = 0x7f7f7f7fu; asm volatile("" : "+v"(one_scale));
    unsigned vA0[2], vA1[2], nA0[2], nA1[2];
    constexpr unsigned hstepA = P::GATHER ? 0u : (unsigned)HALF * P::LDA * 2u;
    if constexpr (P::GATHER) { prob.a_offs(0, cur, R, C, vA0, vA1); }
    else {
#pragma unroll
        for (int i = 0; i < 2; ++i) { vA0[i] = (unsigned)(R[i] * P::LDA + C[i]) * 2u; vA1[i] = vA0[i]; nA0[i] = vA0[i]; nA1[i] = vA0[i]; } }
    unsigned cA = prob.a_soff(cur), cB = prob.b_soff(cur);
    int nt = prob.nt(cur);
    PG8_STAGE_B(PG8_SB(0, 0), rB, cB, vB); PG8_STAGE_B(PG8_SB(0, 1), rB, cB + hstepB, vB); PG8_STAGE(PG8_SA(0, 0), rA, cA, vA0); PG8_STAGE(PG8_SA(0, 1), rA, cA + hstepA, vA1);
    if (wr == 1) PG8_BAR;
    PG8_WAIT_V(2); PG8_BAR;
    PG8_STAGE_B(PG8_SB(1, 0), rB, cB + kstep, vB); PG8_STAGE(PG8_SA(1, 0), rA, cA + kstep, vA0); PG8_STAGE_B(PG8_SB(1, 1), rB, cB + hstepB + kstep, vB);
    PG8_WAIT_V(6); PG8_BAR;
    for (;;) {
        const bool has_next = prob.next(ui + 1, nxt);
        const unsigned nA = has_next ? prob.a_soff(nxt) : cA, nB = has_next ? prob.b_soff(nxt) : cB;
        if constexpr (P::GATHER) { if (has_next) prob.a_offs(ui + 1, nxt, R, C, nA0, nA1); else { nA0[0] = vA0[0]; nA0[1] = vA0[1]; nA1[0] = vA1[0]; nA1[1] = vA1[1]; } }
        for (int t = 0; t < nt; t += 2) {
            const bool last = (t == nt - 2);
            const unsigned a1 = cA + (unsigned)((t + 1) & P::KMASK) * kstep;
            const unsigned a2 = last ? nA : cA + (unsigned)((t + 2) & P::KMASK) * kstep, b2 = last ? nB : cB + (unsigned)((t + 2) & P::KMASK) * kstep;
            const unsigned a3 = last ? nA + kstep : cA + (unsigned)((t + 3) & P::KMASK) * kstep, b3 = last ? nB + kstep : cB + (unsigned)((t + 3) & P::KMASK) * kstep;
            unsigned wA0[2], wA1[2];
            if constexpr (P::GATHER) { wA0[0] = last ? nA0[0] : vA0[0]; wA0[1] = last ? nA0[1] : vA0[1]; wA1[0] = last ? nA1[0] : vA1[0]; wA1[1] = last ? nA1[1] : vA1[1]; }
            else { wA0[0] = vA0[0]; wA0[1] = vA0[1]; wA1[0] = vA0[0]; wA1[1] = vA0[1]; }
            PG8_LDB(B0, 0, 0); PG8_LDB(B1, 0, 1); PG8_SCHED; PG8_LDA(At, 0, 0); PG8_STAGE(PG8_SA(1, 1), rA, a1 + hstepA, vA1);
            PG8_WAIT_V(8); PG8_WAIT_L(0); PG8_BAR; PG8_MMA(0, 0, At, B0); PG8_MMA(0, 1, At, B1); PG8_BAR; PG8_SCHED;
            PG8_LDA(At, 0, 1); PG8_STAGE_B(PG8_SB(0, 0), rB, b2, vB); PG8_STAGE_B(PG8_SB(0, 1), rB, b2 + hstepB, vB); PG8_STAGE(PG8_SA(0, 0), rA, a2, wA0);
            PG8_WAIT_V(8); PG8_WAIT_L(0); PG8_BAR; PG8_MMA(1, 0, At, B0); PG8_MMA(1, 1, At, B1); PG8_BAR; PG8_SCHED;
            PG8_LDB(B0, 1, 0); PG8_LDB(B1, 1, 1); PG8_SCHED; PG8_LDA(At, 1, 0); PG8_STAGE(PG8_SA(0, 1), rA, a2 + hstepA, wA1);
            PG8_WAIT_V(8); PG8_WAIT_L(0); PG8_BAR; PG8_MMA(0, 0, At, B0); PG8_MMA(0, 1, At, B1); PG8_BAR; PG8_SCHED;
            PG8_LDA(At, 1, 1); PG8_STAGE_B(PG8_SB(1, 0), rB, b3, vB); PG8_STAGE_B(PG8_SB(1, 1), rB, b3 + hstepB, vB); PG8_STAGE(PG8_SA(1, 0), rA, a3, wA0);
            PG8_WAIT_V(8); PG8_WAIT_L(0); PG8_BAR; PG8_MMA(1, 0, At, B0); PG8_MMA(1, 1, At, B1); PG8_BAR; PG8_SCHED;
        }
        if constexpr (P::FP8) asm volatile("s_nop 15\n\ts_nop 7" ::: "memory");
        if constexpr (P::ALIGN) { if (wr == 0) PG8_BAR; }
        { int fr_ = fr, fq_ = fq; asm volatile("" : "+v"(fr_), "+v"(fq_));
          prob.epi(acc, cur, wr, wc, fr_, fq_); if constexpr (P::EPIREP > 1) { asm volatile("" : "+v"(fr_), "+v"(fq_) :: "memory"); prob.epi(acc, cur, wr, wc, fr_, fq_); } }
        if (!has_next) break;
        if (!prob.keep_acc(cur)) {
#pragma unroll
        for (int a = 0; a < 2; ++a)
#pragma unroll
            for (int b = 0; b < 2; ++b)
#pragma unroll
                for (int m = 0; m < 4; ++m)
#pragma unroll
                    for (int n = 0; n < 2; ++n) acc[a][b][m][n] = (f32x4){0.f, 0.f, 0.f, 0.f};
        }
        cur = nxt; cA = nA; cB = nB; if constexpr (P::GATHER) { vA0[0] = nA0[0]; vA0[1] = nA0[1]; vA1[0] = nA1[0]; vA1[1] = nA1[1]; } nt = prob.nt(cur); ++ui;
        if constexpr (P::ALIGN) { if (wr == 1) PG8_BAR; }
    }
    PG8_WAIT_V(0);
    if constexpr (!P::ALIGN) { if (wr == 0) PG8_BAR; }
    PG8_BAR;
#undef PG8_SA
#undef PG8_SB
#undef PG8_STAGE
#undef PG8_STAGE_B
#undef PG8_LDA
#undef PG8_LDB
#undef PG8_MMA
#undef PG8_CAT
#undef PG8_WAIT_V
#undef PG8_WAIT_L
#undef PG8_BAR
#undef PG8_SCHED
}
}

struct Args { const float* in[20]; float* out; unsigned char* ws; int ph_lo, ph_hi; };
struct Frame {
    LAS unsigned char* lds;
    unsigned* ctl;
    unsigned char* ws;
    const Args* a;
    int tid, lane, wave, G, bx;
};
#define F_x          (F.a->in[0])
#define F_meta       (F.a->in[1])
#define F_ln_in_g    (F.a->in[2])
#define F_ln_in_b    (F.a->in[3])
#define F_w_in       (F.a->in[4])
#define F_conv_w     (F.a->in[5])
#define F_w_a_out    (F.a->in[6])
#define F_pool_w     (F.a->in[7])
#define F_pool_scale (F.a->in[8])
#define F_w_o        (F.a->in[9])
#define F_ln1_g      (F.a->in[10])
#define F_ln1_b      (F.a->in[11])
#define F_router_w   (F.a->in[12])
#define F_router_b   (F.a->in[13])
#define F_w_gate_up  (F.a->in[14])
#define F_b_gate_up  (F.a->in[15])
#define F_w_down     (F.a->in[16])
#define F_b_down     (F.a->in[17])
#define F_ln2_g      (F.a->in[18])
#define F_ln2_b      (F.a->in[19])
#define F_out        (F.a->out)
#define WSB(off)     ((bf16_t*)(F.ws + (off)))
#define F_Win_t  WSB(WS_WIN_T)
#define F_Wa_t   WSB(WS_WA_T)
#define F_Wo_t   WSB(WS_WO_T)
#define F_Wp_t   WSB(WS_WP_T)
#define F_RWhi   WSB(WS_RW)
#define F_RWlo   WSB(WS_RW + 128 * 1024)
#define F_H0meta WSB(WS_META)
#define F_CUmeta WSB(WS_META + 64 * 1024)
#define F_Vmeta  WSB(WS_META + 128 * 1024)
#define F_H0metaQ ((unsigned char*)(F.ws + WS_META + 160 * 1024))
#define F_Wgu8   ((unsigned char*)(F.ws + WS_WGU_T))
#define F_Wd8    ((unsigned char*)(F.ws + WS_WD_T))
#define F_H1Q    ((unsigned char*)(F.ws + WS_H1Q))
#define F_H0Q    ((unsigned char*)(F.ws + WS_H0Q))
#define F_Win8   ((unsigned char*)(F.ws + WS_WIN8))
#define F_ACT8   ((unsigned char*)(F.ws + WS_ACT))
#define F_H0     WSB(WS_H0)
#define F_BG8    ((unsigned char*)(F.ws + WS_BG))
#define F_CU     WSB(WS_CU)
#define F_V      WSB(WS_V)
#define F_G8     ((unsigned char*)(F.ws + WS_G))
#define F_AP8    ((unsigned char*)(F.ws + WS_AP))
#define F_Wa8    ((unsigned char*)(F.ws + WS_WA_T))
#define F_Wp8    ((unsigned char*)(F.ws + WS_WP_T))
#define F_YB     WSB(WS_YB)
#define F_MERGED8 ((unsigned char*)(F.ws + WS_MERGED))
#define F_Wo8    ((unsigned char*)(F.ws + WS_WO_T))
#define F_H1     WSB(WS_H1)
#define F_OSLOT8 ((unsigned char*)(F.ws + WS_OSLOT))
#define F_MIX    WSB(WS_Z)
#define F_topk_slot ((int*)(F.ws + WS_ROUTE))
#define F_tok_list  ((int*)(F.ws + WS_ROUTE + 1 * MiB))
#define F_wt_list   ((float*)(F.ws + WS_ROUTE + 4 * MiB))


#define QS(i) (((const LAS float*)(F.lds + L_QS))[i])
template <int LDA_>
__device__ __forceinline__ void dense_a_offs(const int (&R)[2], const int (&C)[2], unsigned (&v0)[2], unsigned (&v1)[2]) {
#pragma unroll
    for (int i = 0; i < 2; ++i) { v0[i] = (unsigned)(R[i] * LDA_ + C[i]) * 2u; v1[i] = (unsigned)((R[i] + 128) * LDA_ + C[i]) * 2u; }
}
__device__ __forceinline__ __amdgpu_buffer_rsrc_t mkrsrc(const void* p, size_t bytes) { return __builtin_amdgcn_make_buffer_rsrc((void*)p, 0, (int)(unsigned)bytes, 0x00020000); }
#define EPI_ROW(ai, m) ((ai) * 128 + wr * 64 + (m) * 16 + fr)
#define EPI_COL8(bj) ((bj) * 128 + wc * 32 + 8 * fq)

struct ProbInProj {
    static constexpr bool I8 = false; static constexpr bool B_NT = false; static constexpr bool ALIGN = true; static constexpr int KMASK = (MK_P1_KREP > 1) ? 31 : 0x7fffffff, EPIREP = MK_P1_EPIREP; static constexpr float ASC = 1.0f / MK_P1_KREP; static constexpr bool FP8 = false; static constexpr int LDB = 2048, LDA = 2048; static constexpr bool GATHER = false;
    struct U { int pm, pn; };
    int G, c; const bf16_t *A, *Bt; bf16_t *BG, *CU, *V, *Gt; const float* pool_scale;
    __device__ __forceinline__ bool next(int i, U& u) const { if (!pg8::order_unit(i, G, c, T / 256, NT_BF, u.pm, u.pn)) return false; u.pn = u.pn < 8 ? u.pn : u.pn + 16; return true; }
    __device__ __forceinline__ __amdgpu_buffer_rsrc_t a_rsrc() const { return mkrsrc(A, (size_t)T * 2048 * 2); }
    __device__ __forceinline__ __amdgpu_buffer_rsrc_t b_rsrc() const { return mkrsrc(Bt, (size_t)DIN * 2048 * 2); }
    __device__ __forceinline__ unsigned a_soff(const U& u) const { return (unsigned)u.pm * (256u * 2048u * 2u); }
    __device__ __forceinline__ unsigned b_soff(const U& u) const { return (unsigned)u.pn * (256u * 2048u * 2u); }
    __device__ __forceinline__ int nt(const U&) const { return 32 * MK_P1_KREP; }
    __device__ __forceinline__ bool keep_acc(const U&) const { return false; }
    __device__ __forceinline__ void epi(f32x4 (&acc_)[2][2][4][2], const U& u, int wr, int wc, int fr, int fq) const {
        f32x4 acc[2][2][4][2];
#pragma unroll
        for (int a = 0; a < 2; ++a)
#pragma unroll
            for (int b = 0; b < 2; ++b)
#pragma unroll
                for (int m = 0; m < 4; ++m)
#pragma unroll
                    for (int n = 0; n < 2; ++n) acc[a][b][m][n] = (MK_P1_KREP > 1) ? acc_[a][b][m][n] * ASC : acc_[a][b][m][n];
        const int pn = u.pn; const size_t row0 = (size_t)u.pm * 256;
        if (pn >= 8 && pn < 24) {
            const int cb = (pn - 8) * 128 + wc * 32 + 8 * fq;
#pragma unroll
            for (int ai = 0; ai < 2; ++ai)
#pragma unroll
                for (int m = 0; m < 4; ++m) { const f32x4 p0 = acc[ai][0][m][0] * acc[ai][1][m][0], p1 = acc[ai][0][m][1] * acc[ai][1][m][1];
                    *(u32x4*)(CU + (row0 + EPI_ROW(ai, m)) * 2048 + cb) = pack8(p0, p1); }
        } else if (pn < 28) {
            bf16_t* O; int ldc, cb;
            if (pn < 8) { O = BG; ldc = 2048; cb = pn * 256; } else { O = V; ldc = 1024; cb = (pn - 24) * 256; }
#pragma unroll
            for (int ai = 0; ai < 2; ++ai)
#pragma unroll
                for (int m = 0; m < 4; ++m)
#pragma unroll
                    for (int bj = 0; bj < 2; ++bj) *(u32x4*)(O + (row0 + EPI_ROW(ai, m)) * ldc + cb + EPI_COL8(bj)) = pack8(acc[ai][bj][m][0], acc[ai][bj][m][1]);
        }
    }
};

struct ProbInProj8 {
    static constexpr bool I8 = true; static constexpr bool B_NT = false; static constexpr bool ALIGN = MK_ALIGN8; static constexpr int KMASK = 0x7fffffff, EPIREP = 1; static constexpr bool FP8 = false; static constexpr int LDB = 1024, LDA = 1024; static constexpr bool GATHER = false;
    struct U { int pm, pn; };
    int G, c; const unsigned char *A8, *B8; bf16_t *CU, *V; unsigned char *BG8, *G8; float deq, bgq;
    __device__ __forceinline__ bool next(int i, U& u) const { if (!pg8::order_unit(i, G, c, T / 256, 44 - NT_BF, u.pm, u.pn)) return false; if (!MK_ALL_FP8) u.pn = u.pn < 16 ? u.pn + 8 : u.pn + 12; return true; }
    __device__ __forceinline__ __amdgpu_buffer_rsrc_t a_rsrc() const { return mkrsrc(A8, (size_t)T * 2048); }
    __device__ __forceinline__ __amdgpu_buffer_rsrc_t b_rsrc() const { return mkrsrc(B8, (size_t)DIN * 2048); }
    __device__ __forceinline__ unsigned a_soff(const U& u) const { return (unsigned)u.pm * (256u * 2048u); }
    __device__ __forceinline__ unsigned b_soff(const U& u) const { return (unsigned)u.pn * (256u * 2048u); }
    __device__ __forceinline__ int nt(const U&) const { return 16; }
    __device__ __forceinline__ bool keep_acc(const U&) const { return false; }
    __device__ __forceinline__ void epi(f32x4 (&acc)[2][2][4][2], const U& u, int wr, int wc, int fr, int fq) const {
        const int pn = u.pn; const size_t row0 = (size_t)u.pm * 256;
        const float DEQ = deq;
        if (pn >= 8 && pn < 24) {
            const int cb = (pn - 8) * 128 + wc * 32 + 8 * fq;
#pragma unroll
            for (int ai = 0; ai < 2; ++ai)
#pragma unroll
                for (int m = 0; m < 4; ++m) { const f32x4 p0 = i2f(acc[ai][0][m][0]) * i2f(acc[ai][1][m][0]) * (DEQ * DEQ), p1 = i2f(acc[ai][0][m][1]) * i2f(acc[ai][1][m][1]) * (DEQ * DEQ);
                    *(u32x4*)(CU + (row0 + EPI_ROW(ai, m)) * 2048 + cb) = pack8(p0, p1); }
        } else if (pn < 28) {
            if (pn < 8) {
                const int cb = pn * 256; const float qf = DEQ * bgq;
#pragma unroll
                for (int ai = 0; ai < 2; ++ai)
#pragma unroll
                    for (int m = 0; m < 4; ++m)
#pragma unroll
                        for (int bj = 0; bj < 2; ++bj) { const f32x4 v0 = i2f(acc[ai][bj][m][0]) * qf, v1 = i2f(acc[ai][bj][m][1]) * qf; u32x2 w; w.x = pack4_i8(v0[0], v0[1], v0[2], v0[3]); w.y = pack4_i8(v1[0], v1[1], v1[2], v1[3]);
                            *(u32x2*)(BG8 + (row0 + EPI_ROW(ai, m)) * 2048 + cb + EPI_COL8(bj)) = w; }
            } else {
                const int cb = (pn - 24) * 256;
#pragma unroll
                for (int ai = 0; ai < 2; ++ai)
#pragma unroll
                    for (int m = 0; m < 4; ++m)
#pragma unroll
                        for (int bj = 0; bj < 2; ++bj) *(u32x4*)(V + (row0 + EPI_ROW(ai, m)) * 1024 + cb + EPI_COL8(bj)) = pack8(i2f(acc[ai][bj][m][0]) * DEQ, i2f(acc[ai][bj][m][1]) * DEQ);
            }
        } else {
            const int cb = (pn - 28) * 256;
#pragma unroll
            for (int ai = 0; ai < 2; ++ai)
#pragma unroll
                for (int m = 0; m < 4; ++m)
#pragma unroll
                    for (int bj = 0; bj < 2; ++bj) { f32x4 s0, s1;
#pragma unroll
                        for (int j = 0; j < 4; j += 2) {
                            const f32x4 c0 = i2f(acc[ai][bj][m][0]), c1 = i2f(acc[ai][bj][m][1]);
                            const f32x2 e0 = (f32x2){c0[j], c0[j + 1]} * (-DEQ * 1.4426950408889634f), e1 = (f32x2){c1[j], c1[j + 1]} * (-DEQ * 1.4426950408889634f);
                            f32x2 d0, d1; d0.x = __builtin_amdgcn_exp2f(e0.x); d0.y = __builtin_amdgcn_exp2f(e0.y); d1.x = __builtin_amdgcn_exp2f(e1.x); d1.y = __builtin_amdgcn_exp2f(e1.y); d0 = d0 + 1.0f; d1 = d1 + 1.0f;
                            f32x2 r0, r1; r0.x = __builtin_amdgcn_rcpf(d0.x); r0.y = __builtin_amdgcn_rcpf(d0.y); r1.x = __builtin_amdgcn_rcpf(d1.x); r1.y = __builtin_amdgcn_rcpf(d1.y);
                            r0 = r0 * 255.0f; r1 = r1 * 255.0f;
                            s0[j] = r0.x; s0[j + 1] = r0.y; s1[j] = r1.x; s1[j + 1] = r1.y; }
                        u32x2 w; w.x = pack4_u8(s0[0], s0[1], s0[2], s0[3]); w.y = pack4_u8(s1[0], s1[1], s1[2], s1[3]);
                        *(u32x2*)(G8 + (row0 + EPI_ROW(ai, m)) * 4096 + cb + EPI_COL8(bj)) = w; }
        }
    }
};

struct ProbMix {
    static constexpr bool I8 = false; static constexpr bool B_NT = false; static constexpr bool ALIGN = true; static constexpr int KMASK = 0x7fffffff, EPIREP = 1; static constexpr bool FP8 = true; static constexpr int LDB = 1024, LDA = APITCH / 2; static constexpr bool GATHER = false;
    struct U { int pm, pn, type; };
    int G, c; const unsigned char *AP, *Wp_t, *Wa_t; const unsigned char* G8; const float* pool_scale; bf16_t* YB; unsigned char* MERGED;
    __device__ __forceinline__ bool next(int i, U& u) const { u.type = i & 1; return pg8::order_unit(i >> 1, G, c, T / 256, D / 256, u.pm, u.pn); }
    __device__ __forceinline__ __amdgpu_buffer_rsrc_t a_rsrc() const { return mkrsrc(AP, (size_t)T * APITCH); }
    __device__ __forceinline__ __amdgpu_buffer_rsrc_t b_rsrc() const { return mkrsrc(Wa_t, (size_t)(WS_WP_T - WS_WA_T) + (size_t)2048 * 2048); }
    __device__ __forceinline__ unsigned a_soff(const U& u) const { return (unsigned)u.pm * (256u * APITCH) + (u.type == 0 ? 2048u + (unsigned)(u.pn >> 1) * 256u : 0u); }
    __device__ __forceinline__ unsigned b_soff(const U& u) const { return (u.type == 0 ? (unsigned)(WS_WP_T - WS_WA_T) : 0u) + (unsigned)u.pn * (256u * 2048u); }
    __device__ __forceinline__ int nt(const U& u) const { return u.type == 0 ? 2 : 16; }
    __device__ __forceinline__ bool keep_acc(const U& u) const { return u.type == 0; }
    __device__ __forceinline__ void epi(f32x4 (&acc)[2][2][4][2], const U& u, int wr, int wc, int fr, int fq) const {
        const size_t row0 = (size_t)u.pm * 256; const int cb = u.pn * 256;
        if (u.type == 0) {
            f32x4 ps[2][2];
#pragma unroll
            for (int bj = 0; bj < 2; ++bj)
#pragma unroll
                for (int n = 0; n < 2; ++n) ps[bj][n] = *(const f32x4*)(pool_scale + cb + EPI_COL8(bj) + 4 * n) * (P3_WA_SCALE / P3_WP_SCALE);
#pragma unroll
            for (int ai = 0; ai < 2; ++ai) { u32x2 gaw[4][2], gbw[4][2];
#pragma unroll
                for (int m = 0; m < 4; ++m) { const size_t r = row0 + EPI_ROW(ai, m);
#pragma unroll
                    for (int bj = 0; bj < 2; ++bj) { gaw[m][bj] = *(const u32x2*)(G8 + r * 4096 + cb + EPI_COL8(bj)); gbw[m][bj] = *(const u32x2*)(G8 + r * 4096 + 2048 + cb + EPI_COL8(bj)); } }
#pragma unroll
                for (int m = 0; m < 4; ++m)
#pragma unroll
                    for (int bj = 0; bj < 2; ++bj) { const f32x4 g0 = u8x4_to_f(gaw[m][bj].x), g1 = u8x4_to_f(gaw[m][bj].y), h0 = u8x4_to_f(gbw[m][bj].x) * ps[bj][0], h1 = u8x4_to_f(gbw[m][bj].y) * ps[bj][1];
#pragma unroll
                        for (int j = 0; j < 4; ++j) { acc[ai][bj][m][0][j] *= h0[j] * __builtin_amdgcn_rcpf(g0[j]); acc[ai][bj][m][1][j] *= h1[j] * __builtin_amdgcn_rcpf(g1[j]); } }
                asm volatile("" ::: "memory"); }
        } else {
            u32x2 gaw[2][4][2];
#pragma unroll
            for (int ai = 0; ai < 2; ++ai)
#pragma unroll
                for (int m = 0; m < 4; ++m)
#pragma unroll
                    for (int bj = 0; bj < 2; ++bj) gaw[ai][m][bj] = *(const u32x2*)(G8 + (row0 + EPI_ROW(ai, m)) * 4096 + cb + EPI_COL8(bj));
#pragma unroll
            for (int ai = 0; ai < 2; ++ai)
#pragma unroll
                for (int m = 0; m < 4; ++m)
#pragma unroll
                    for (int bj = 0; bj < 2; ++bj) { const f32x4 g0 = u8x4_to_f(gaw[ai][m][bj].x) * (P4_M_SCALE / (255.0f * P3_A_SCALE * P3_WA_SCALE)), g1 = u8x4_to_f(gaw[ai][m][bj].y) * (P4_M_SCALE / (255.0f * P3_A_SCALE * P3_WA_SCALE));
                        const f32x4 o0 = acc[ai][bj][m][0] * g0, o1 = acc[ai][bj][m][1] * g1; u32x2 w8; w8.x = pack4_fp8(clamp448(o0[0]), clamp448(o0[1]), clamp448(o0[2]), clamp448(o0[3])); w8.y = pack4_fp8(clamp448(o1[0]), clamp448(o1[1]), clamp448(o1[2]), clamp448(o1[3]));
                        *(u32x2*)(MERGED + (row0 + EPI_ROW(ai, m)) * 2048 + cb + EPI_COL8(bj)) = w8; }
        }
    }
};

struct ProbWo {
    static constexpr bool I8 = false; static constexpr bool B_NT = false; static constexpr bool ALIGN = true; static constexpr int KMASK = (MK_P4_KREP > 1) ? 15 : 0x7fffffff, EPIREP = 1; static constexpr bool FP8 = true; static constexpr int LDB = 1024, LDA = 1024; static constexpr bool GATHER = false;
    struct U { int pm, pn; };
    int G, c; const unsigned char *A, *Bt; bf16_t* MIX;
    __device__ __forceinline__ bool next(int i, U& u) const { return pg8::order_unit(i, G, c, T / 256, D / 256, u.pm, u.pn); }
    __device__ __forceinline__ __amdgpu_buffer_rsrc_t a_rsrc() const { return mkrsrc(A, (size_t)T * 2048); }
    __device__ __forceinline__ __amdgpu_buffer_rsrc_t b_rsrc() const { return mkrsrc(Bt, (size_t)2048 * 2048); }
    __device__ __forceinline__ unsigned a_soff(const U& u) const { return (unsigned)u.pm * (256u * 2048u); }
    __device__ __forceinline__ unsigned b_soff(const U& u) const { return (unsigned)u.pn * (256u * 2048u); }
    __device__ __forceinline__ int nt(const U&) const { return 16 * MK_P4_KREP; }
    __device__ __forceinline__ bool keep_acc(const U&) const { return false; }
    __device__ __forceinline__ void epi(f32x4 (&acc)[2][2][4][2], const U& u, int wr, int wc, int fr, int fq) const {
        const size_t row0 = (size_t)u.pm * 256; const int cb = u.pn * 256;
#pragma unroll
        for (int ai = 0; ai < 2; ++ai)
#pragma unroll
            for (int m = 0; m < 4; ++m)
#pragma unroll
                for (int bj = 0; bj < 2; ++bj) *(u32x4*)(MIX + (row0 + EPI_ROW(ai, m)) * 2048 + cb + EPI_COL8(bj)) = pack8(acc[ai][bj][m][0] * (1.0f / (MK_P4_KREP * P4_M_SCALE * P4_WO_SCALE)), acc[ai][bj][m][1] * (1.0f / (MK_P4_KREP * P4_M_SCALE * P4_WO_SCALE)));
    }
};

__device__ __forceinline__ int moe_build_tables(Frame& F) {
    LAS int* cntl = (LAS int*)(F.lds + L_CNT); LAS int* tbase = (LAS int*)(F.lds + L_TBASE); LAS int* tile_e = (LAS int*)(F.lds + L_TILE_E);
    if (F.tid < 64) {
        const int e = F.tid & 31; const int cnt = (int)__hip_atomic_load(F.ctl + CW_CNT + e, RLX_AGENT); const int ntile = (cnt + 255) >> 8;
        int incl = ntile;
#pragma unroll
        for (int o = 1; o < 32; o <<= 1) { const int v = __shfl_up(incl, o, 32); if (e >= o) incl += v; }
        if (F.tid < 32) { cntl[e] = cnt; tbase[e] = incl - ntile; if (e == 31) tbase[32] = incl; }
    }
    __syncthreads();
    const int NT = __builtin_amdgcn_readfirstlane(tbase[32]);
    for (int rt = F.tid; rt < NT; rt += NTHREADS) { int e = 0;
#pragma unroll 1
        for (int k = 1; k < 32; ++k) if (tbase[k] <= rt) e = k;
        tile_e[rt] = e; }
    __syncthreads();
    return NT;
}

__device__ __forceinline__ bool moe_unit(int i, int G, int c, int NT, int NN, const LAS int* tbase, int& rt, int& j, int& e) {
    const int nwg = NT * NN; const long L = (long)i * G + c; if (L >= nwg) return false;
    int wgid = (int)L; { const int q = nwg / 8, xcd = wgid % 8, off = wgid / 8; wgid = xcd * q + off; }
    const int lane = threadIdx.x & 63;
    const int tb = tbase[lane < 32 ? lane : 32];
    e = __builtin_popcountll(__ballot(tb * NN <= wgid)) - 1;
    const int t0 = __builtin_amdgcn_readfirstlane(tbase[e]), t1 = __builtin_amdgcn_readfirstlane(tbase[e + 1]);
    const int local = wgid - t0 * NN, gsz = t1 - t0;
    rt = t0 + local % gsz; j = local / gsz; return true;
}

struct ProbGateUp {
    static constexpr bool I8 = true; static constexpr bool B_NT = MK_B_NT; static constexpr bool ALIGN = MK_ALIGN8; static constexpr int KMASK = (MK_P6_KREP > 1) ? 15 : 0x7fffffff, EPIREP = MK_P6_EPIREP; static constexpr bool FP8 = false; static constexpr int LDB = 1024, LDA = 1024; static constexpr bool GATHER = true;
    struct U { int rt, j, e; };
    int G, c, NT; LAS unsigned char* lds; const unsigned char *H1Q, *Wgu8; const float* b_gate_up; unsigned char* ACT8;
    __device__ __forceinline__ bool next(int i, U& u) const { return moe_unit(i, G, c, NT, 16, (const LAS int*)(lds + L_TBASE), u.rt, u.j, u.e); }
    __device__ __forceinline__ __amdgpu_buffer_rsrc_t a_rsrc() const { return mkrsrc(H1Q, (size_t)T * 2048); }
    __device__ __forceinline__ __amdgpu_buffer_rsrc_t b_rsrc() const { return mkrsrc(Wgu8, (size_t)NE * 4096 * 2048); }
    __device__ __forceinline__ unsigned a_soff(const U&) const { return 0u; }
    __device__ __forceinline__ unsigned b_soff(const U& u) const { return ((unsigned)u.e * 4096u + (unsigned)u.j * 256u) * 2048u; }
    __device__ __forceinline__ int nt(const U&) const { return 16 * MK_P6_KREP; }
    __device__ __forceinline__ void a_offs(int ui, const U&, const int (&R)[2], const int (&C)[2], unsigned (&v0)[2], unsigned (&v1)[2]) const {
        const LAS int* rows = (const LAS int*)(lds + L_ROWS) + ui * 256;
#pragma unroll
        for (int i = 0; i < 2; ++i) { v0[i] = (unsigned)rows[R[i]] * 2048u + (unsigned)C[i] * 2u; v1[i] = (unsigned)rows[128 + R[i]] * 2048u + (unsigned)C[i] * 2u; }
    }
    __device__ __forceinline__ bool keep_acc(const U&) const { return false; }
    __device__ __forceinline__ void epi(f32x4 (&acc)[2][2][4][2], const U& u, int wr, int wc, int fr, int fq) const {
        const size_t row0 = (size_t)u.rt * 256; const int cb = u.j * 128 + wc * 32 + 8 * fq;
        const float* bp = b_gate_up + (size_t)u.e * 4096 + cb;
        const float DEQ = 1.0f / (((const LAS float*)(lds + L_QS))[1] * ((const LAS float*)(lds + L_QS))[3 + u.e] * MK_P6_KREP);
        f32x4 bg[2], bl1[2];
#pragma unroll
        for (int n = 0; n < 2; ++n) { bg[n] = *(const f32x4*)(bp + 4 * n); bl1[n] = *(const f32x4*)(bp + 2048 + 4 * n) + 1.0f; }
#pragma unroll
        for (int ai = 0; ai < 2; ++ai)
#pragma unroll
            for (int mp = 0; mp < 2; ++mp) { u32x2 w[2];
#pragma unroll
                for (int mm = 0; mm < 2; ++mm) { const int m = 2 * mp + mm; f32x4 o[2];
#pragma unroll
                    for (int n = 0; n < 2; ++n)
#pragma unroll
                        for (int j = 0; j < 4; j += 2) {
                            const f32x4 cg = i2f(acc[ai][0][m][n]), cl = i2f(acc[ai][1][m][n]);
                            f32x2 g = (f32x2){cg[j], cg[j + 1]} * DEQ + (f32x2){bg[n][j], bg[n][j + 1]};
                            f32x2 l = (f32x2){cl[j], cl[j + 1]} * DEQ + (f32x2){bl1[n][j], bl1[n][j + 1]};
                            g.x = fminf(g.x, SW_LIMIT); g.y = fminf(g.y, SW_LIMIT);
                            l.x = __builtin_amdgcn_fmed3f(l.x, 1.0f - SW_LIMIT, 1.0f + SW_LIMIT); l.y = __builtin_amdgcn_fmed3f(l.y, 1.0f - SW_LIMIT, 1.0f + SW_LIMIT);
                            const f32x2 e = g * (-SW_ALPHA * 1.4426950408889634f); f32x2 d; d.x = __builtin_amdgcn_exp2f(e.x); d.y = __builtin_amdgcn_exp2f(e.y); d = d + 1.0f;
                            f32x2 r; r.x = __builtin_amdgcn_rcpf(d.x); r.y = __builtin_amdgcn_rcpf(d.y);
                            const f32x2 out = (l * (g * ACT_SCALE)) * r; o[n][j] = out.x; o[n][j + 1] = out.y; }
                    w[mm].x = pack4_fp8(o[0][0], o[0][1], o[0][2], o[0][3]); w[mm].y = pack4_fp8(o[1][0], o[1][1], o[1][2], o[1][3]); }
                const auto sx = __builtin_amdgcn_permlane16_swap(w[0].x, w[1].x, false, false); const auto sy = __builtin_amdgcn_permlane16_swap(w[0].y, w[1].y, false, false);
                u32x4 q; q.x = sx[0]; q.y = sy[0]; q.z = sx[1]; q.w = sy[1];
                const int odd = fq & 1; const int m = 2 * mp + odd;
                *(u32x4*)(ACT8 + (row0 + EPI_ROW(ai, m)) * 2048 + u.j * 128 + wc * 32 + 8 * (fq - odd)) = q; }
    }
};

struct ProbDown {
    static constexpr bool I8 = false; static constexpr bool B_NT = MK_B_NT; static constexpr bool ALIGN = MK_ALIGN8; static constexpr int KMASK = 0x7fffffff, EPIREP = MK_P7_EPIREP; static constexpr bool FP8 = true; static constexpr int LDB = 1024, LDA = 1024; static constexpr bool GATHER = false;
    struct U { int rt, j, e; };
    int G, c, NT; LAS unsigned char* lds; const unsigned char *ACT8, *Wd8; const float *b_down, *wt_list; unsigned char* OSLOT8;
    __device__ __forceinline__ bool next(int i, U& u) const { return moe_unit(i, G, c, NT, 8, (const LAS int*)(lds + L_TBASE), u.rt, u.j, u.e); }
    __device__ __forceinline__ __amdgpu_buffer_rsrc_t a_rsrc() const { return mkrsrc(ACT8, (size_t)MAXTILES * 256 * 2048); }
    __device__ __forceinline__ __amdgpu_buffer_rsrc_t b_rsrc() const { return mkrsrc(Wd8, (size_t)NE * 2048 * 2048); }
    __device__ __forceinline__ unsigned a_soff(const U& u) const { return (unsigned)u.rt * (256u * 2048u); }
    __device__ __forceinline__ unsigned b_soff(const U& u) const { return ((unsigned)u.e * 2048u + (unsigned)u.j * 256u) * 2048u; }
    __device__ __forceinline__ int nt(const U&) const { return 16; }
    __device__ __forceinline__ bool keep_acc(const U&) const { return false; }
    __device__ __forceinline__ void epi(f32x4 (&acc)[2][2][4][2], const U& u, int wr, int wc, int fr, int fq) const {
        const size_t row0 = (size_t)u.rt * 256; const int cb = u.j * 256;
        const int cnt = __builtin_amdgcn_readfirstlane(((const LAS int*)(lds + L_CNT))[u.e]), r0 = (u.rt - __builtin_amdgcn_readfirstlane(((const LAS int*)(lds + L_TBASE))[u.e])) * 256;
        constexpr float DEQ = 1.0f / (ACT_SCALE * W_SCALE_D);
        const float* bp = b_down + (size_t)u.e * 2048 + cb + wc * 32 + 8 * fq; const float* wp = wt_list + (size_t)u.e * T;
        float wt[2][4]; f32x4 bv[2][2];
#pragma unroll
        for (int ai = 0; ai < 2; ++ai)
#pragma unroll
            for (int m = 0; m < 4; ++m) { const int idx = r0 + EPI_ROW(ai, m); wt[ai][m] = wp[idx < cnt ? idx : 0]; if (idx >= cnt) wt[ai][m] = 0.f; }
#pragma unroll
        for (int bj = 0; bj < 2; ++bj) { bv[bj][0] = *(const f32x4*)(bp + bj * 128); bv[bj][1] = *(const f32x4*)(bp + bj * 128 + 4); }
#pragma unroll
        for (int ai = 0; ai < 2; ++ai)
#pragma unroll
            for (int mp = 0; mp < 2; ++mp)
#pragma unroll
                for (int bj = 0; bj < 2; ++bj) { u32x2 w[2];
#pragma unroll
                    for (int mm = 0; mm < 2; ++mm) { const int m = 2 * mp + mm; const float ws = wt[ai][m] * OS_SCALE;
                        const f32x4 o0 = (acc[ai][bj][m][0] * DEQ + bv[bj][0]) * ws, o1 = (acc[ai][bj][m][1] * DEQ + bv[bj][1]) * ws;
                        w[mm].x = pack4_fp8(clamp448(o0[0]), clamp448(o0[1]), clamp448(o0[2]), clamp448(o0[3])); w[mm].y = pack4_fp8(clamp448(o1[0]), clamp448(o1[1]), clamp448(o1[2]), clamp448(o1[3])); }
                    const auto sx = __builtin_amdgcn_permlane16_swap(w[0].x, w[1].x, false, false); const auto sy = __builtin_amdgcn_permlane16_swap(w[0].y, w[1].y, false, false);
                    u32x4 q; q.x = sx[0]; q.y = sy[0]; q.z = sx[1]; q.w = sy[1];
                    const int odd = fq & 1; const int m = 2 * mp + odd;
                    *(u32x4*)(OSLOT8 + (row0 + EPI_ROW(ai, m)) * 2048 + cb + bj * 128 + wc * 32 + 8 * (fq - odd)) = q; }
    }
};

__device__ __forceinline__ void transpose_item(const float* W, int N, bf16_t* WT, int pitch, int k0, int n0, int drow0, int lane) {
    const int kq = lane & 7, ng = lane >> 3;
    const GAS float* src = (const GAS float*)(W + (size_t)(k0 + 8 * kq) * N + n0 + 4 * ng);
    f32x4 x[8];
#pragma unroll
    for (int i = 0; i < 8; ++i) x[i] = *(const GAS f32x4*)(src + (size_t)i * N);
    GAS bf16_t* dst = (GAS bf16_t*)(WT + (size_t)(drow0 + 4 * ng) * pitch + k0 + 8 * kq);
#pragma unroll
    for (int c = 0; c < 4; ++c) { u32x4 o; o.x = cvt_pk_bf16(x[0][c], x[1][c]); o.y = cvt_pk_bf16(x[2][c], x[3][c]); o.z = cvt_pk_bf16(x[4][c], x[5][c]); o.w = cvt_pk_bf16(x[6][c], x[7][c]);
        *(GAS u32x4*)(dst + (size_t)c * pitch) = o; }
}
template <bool I8>
__device__ __forceinline__ void transpose_item_q8(const float* W, int N, unsigned char* WT, int pitch, int k0, int n0, int drow0, float scale, int lane) {
    const int kq = lane & 7, ng = lane >> 3;
    const GAS float* src = (const GAS float*)(W + (size_t)(k0 + 16 * kq) * N + n0 + 4 * ng);
    f32x4 x[16];
#pragma unroll
    for (int i = 0; i < 16; ++i) x[i] = __builtin_nontemporal_load((const GAS f32x4*)(src + (size_t)i * N));
    GAS unsigned char* dst = (GAS unsigned char*)(WT + (size_t)(drow0 + 4 * ng) * pitch + k0 + 16 * kq);
#pragma unroll
    for (int c = 0; c < 4; ++c) { u32x4 o;
#pragma unroll
        for (int d = 0; d < 4; ++d) o[d] = I8 ? pack4_i8(x[4 * d][c] * scale, x[4 * d + 1][c] * scale, x[4 * d + 2][c] * scale, x[4 * d + 3][c] * scale) : pack4_fp8(x[4 * d][c] * scale, x[4 * d + 1][c] * scale, x[4 * d + 2][c] * scale, x[4 * d + 3][c] * scale);
        __builtin_nontemporal_store(o, (GAS u32x4*)(dst + (size_t)c * pitch)); }
}
__device__ __forceinline__ void q8_load(const float* W, int N, int k0, int n0, int lane, f32x4 (&x)[16]) {
    const int kq = lane & 7, ng = lane >> 3;
    const GAS float* src = (const GAS float*)(W + (size_t)(k0 + 16 * kq) * N + n0 + 4 * ng);
#pragma unroll
    for (int i = 0; i < 16; ++i) x[i] = __builtin_nontemporal_load((const GAS f32x4*)(src + (size_t)i * N));
}
template <bool I8>
__device__ __forceinline__ void q8_store(const f32x4 (&x)[16], unsigned char* WT, int pitch, int k0, int drow0, float scale, int lane) {
    const int kq = lane & 7, ng = lane >> 3;
    GAS unsigned char* dst = (GAS unsigned char*)(WT + (size_t)(drow0 + 4 * ng) * pitch + k0 + 16 * kq);
#pragma unroll
    for (int c = 0; c < 4; ++c) { u32x4 o;
#pragma unroll
        for (int d = 0; d < 4; ++d) o[d] = I8 ? pack4_i8(x[4 * d][c] * scale, x[4 * d + 1][c] * scale, x[4 * d + 2][c] * scale, x[4 * d + 3][c] * scale) : pack4_fp8(x[4 * d][c] * scale, x[4 * d + 1][c] * scale, x[4 * d + 2][c] * scale, x[4 * d + 3][c] * scale);
        __builtin_nontemporal_store(o, (GAS u32x4*)(dst + (size_t)c * pitch)); }
}
__device__ __forceinline__ int vrow_in(int n) {
    if (n >= 2048 && n < 4096) { const int j = n - 2048; return 2048 + 256 * (j >> 7) + (j & 127); }
    if (n >= 4096 && n < 6144) { const int j = n - 4096; return 2048 + 256 * (j >> 7) + 128 + (j & 127); }
    return n;
}
__device__ __forceinline__ int vrow_gu(int n) { return n < 2048 ? 256 * (n >> 7) + (n & 127) : 256 * ((n - 2048) >> 7) + 128 + (n & 127); }
__device__ __forceinline__ void ln_row_to_bf16(const float* xrow, const float* g, const float* b, bf16_t* orow, unsigned char* qrow, float qscale, int lane) {
    const GAS f32x4* xr = (const GAS f32x4*)xrow + lane;
    f32x4 v[8]; float s = 0.f;
#pragma unroll
    for (int j = 0; j < 8; ++j) { v[j] = __builtin_nontemporal_load(xr + 64 * j); s += (v[j].x + v[j].y) + (v[j].z + v[j].w); }
    const float mean = wave_sum(s) * (1.f / D); float s2 = 0.f;
#pragma unroll
    for (int j = 0; j < 8; ++j) { v[j] = v[j] - mean; s2 += (v[j].x * v[j].x + v[j].y * v[j].y) + (v[j].z * v[j].z + v[j].w * v[j].w); }
    const float rstd = 1.f / sqrtf(wave_sum(s2) * (1.f / D) + LN_EPS);
    GAS u32x2* o8 = (GAS u32x2*)orow + lane;
#pragma unroll
    for (int j = 0; j < 8; ++j) { const f32x4 gg = *((const GAS f32x4*)g + lane + 64 * j), bb = *((const GAS f32x4*)b + lane + 64 * j); const f32x4 y = v[j] * rstd * gg + bb;
        u32x2 w; w.x = cvt_pk_bf16(y.x, y.y); w.y = cvt_pk_bf16(y.z, y.w); o8[64 * j] = w;
        if (qrow) *((GAS unsigned*)qrow + lane + 64 * j) = pack4_i8(y.x * qscale, y.y * qscale, y.z * qscale, y.w * qscale); }
}
constexpr int CV_GU = NE * 16 * 128, CV_D = NE * 16 * 64, CV_TOTAL = CV_GU + CV_D;
__device__ __forceinline__ void conv_item(Frame& F, int r) {
    f32x4 x0[16];
    if (r < CV_GU) { const int e = r / (16 * 128), q = r % (16 * 128), kb = q / 128, nb = q % 128; const float* W = F_w_gate_up + (size_t)e * 2048 * 4096; unsigned char* WT = F_Wgu8 + (size_t)e * 4096 * 2048;
        q8_load(W, 4096, 128 * kb, 32 * nb, F.lane, x0); q8_store<true>(x0, WT, 2048, 128 * kb, vrow_gu(32 * nb), QS(3 + e), F.lane); }
    else { r -= CV_GU; const int e = r / (16 * 64), q = r % (16 * 64), kb = q / 64, nb = q % 64; const float* W = F_w_down + (size_t)e * 2048 * 2048; unsigned char* WT = F_Wd8 + (size_t)e * 2048 * 2048;
        q8_load(W, 2048, 128 * kb, 32 * nb, F.lane, x0); q8_store<false>(x0, WT, 2048, 128 * kb, 32 * nb, W_SCALE_D, F.lane); }
}
__device__ __forceinline__ void conv_pair(Frame& F, int r) {
    f32x4 x0[16], x1[16];
    if (r < CV_GU) { const int e = r / (16 * 128), q = r % (16 * 128), kb = q / 128, nb = q % 128; const float* W = F_w_gate_up + (size_t)e * 2048 * 4096; unsigned char* WT = F_Wgu8 + (size_t)e * 4096 * 2048;
        q8_load(W, 4096, 128 * kb, 32 * nb, F.lane, x0); q8_load(W, 4096, 128 * kb, 32 * nb + 32, F.lane, x1);
        q8_store<true>(x0, WT, 2048, 128 * kb, vrow_gu(32 * nb), QS(3 + e), F.lane); q8_store<true>(x1, WT, 2048, 128 * kb, vrow_gu(32 * nb + 32), QS(3 + e), F.lane); }
    else { r -= CV_GU; const int e = r / (16 * 64), q = r % (16 * 64), kb = q / 64, nb = q % 64; const float* W = F_w_down + (size_t)e * 2048 * 2048; unsigned char* WT = F_Wd8 + (size_t)e * 2048 * 2048;
        q8_load(W, 2048, 128 * kb, 32 * nb, F.lane, x0); q8_load(W, 2048, 128 * kb, 32 * nb + 32, F.lane, x1);
        q8_store<false>(x0, WT, 2048, 128 * kb, 32 * nb, W_SCALE_D, F.lane); q8_store<false>(x1, WT, 2048, 128 * kb, 32 * nb + 32, W_SCALE_D, F.lane); }
}
constexpr int CV_NQ = 8, CV_QL = CV_TOTAL / CV_NQ;
__device__ __forceinline__ int conv_grab(Frame& F, int& q, int cbase = CW_CONV) {
    for (int tries = 0; tries < CV_NQ; ++tries) {
        int v = 0; if (F.lane == 0) v = (int)__hip_atomic_fetch_add(F.ctl + cbase + 32 * q, (unsigned)MK_CONV_N, RLX_AGENT);
        v = __builtin_amdgcn_readfirstlane(v);
        if (MK_CONVWRAP && cbase != CW_CONV) return q * CV_QL + (int)((unsigned)v % (unsigned)CV_QL);
        if (v < CV_QL) return q * CV_QL + v;
        q = (q + 1) & (CV_NQ - 1);
    }
    return -1;
}
__device__ __forceinline__ void conv_worker(Frame& F, int gd_word, int n_gemm, int cbase = CW_CONV) {
    if (gd_word >= 0) { int g = 0; if (F.lane == 0) g = (int)__hip_atomic_load(F.ctl + gd_word, RLX_AGENT); if (__builtin_amdgcn_readfirstlane(g) >= n_gemm) return; }
    int q = (int)(xb_xcc_id() & (CV_NQ - 1));
    int cur = conv_grab(F, q, cbase);
    bool stop = false;
    while (cur >= 0) {
        int nx = 0, g = 0;
        if (!stop && F.lane == 0) { nx = (int)__hip_atomic_fetch_add(F.ctl + cbase + 32 * q, (unsigned)MK_CONV_N, RLX_AGENT); if (gd_word >= 0) g = (int)__hip_atomic_load(F.ctl + gd_word, RLX_AGENT); }
        if (MK_CONV_N == 2) conv_pair(F, cur); else conv_item(F, cur);
        if (stop) break;
        nx = __builtin_amdgcn_readfirstlane(nx); g = __builtin_amdgcn_readfirstlane(g);
        if (gd_word >= 0 && g >= n_gemm) stop = true;
        if (MK_CONVWRAP && cbase != CW_CONV) nx = (int)((unsigned)nx % (unsigned)CV_QL);
        if (nx < CV_QL) cur = q * CV_QL + nx;
        else if (stop) break;
        else { q = (q + 1) & (CV_NQ - 1); cur = conv_grab(F, q, cbase); }
    }
}
__device__ __forceinline__ void conv_cleanup(Frame& F) {
    int c = CV_QL; if (F.lane < CV_NQ) c = (int)__hip_atomic_load(F.ctl + CW_CONV + 32 * F.lane, RLX_AGENT);
    c = c < CV_QL ? c : CV_QL;
    const int rem = CV_QL - c;
    int incl = rem;
#pragma unroll
    for (int d = 1; d < CV_NQ; d <<= 1) { const int o = __shfl_up(incl, d); if (F.lane >= d) incl += o; }
    const int total = __builtin_amdgcn_readlane(incl, CV_NQ - 1);
    const int first = F.lane * CV_QL + c - (incl - rem);
    const int gw = F.bx * NWAVES + F.wave, NGW = F.G * NWAVES;
    for (int i = MK_CONV_N * gw; i < total; i += MK_CONV_N * NGW) {
        const int qi = __builtin_popcountll(__ballot(F.lane < CV_NQ && incl <= i));
        const int it = __builtin_amdgcn_readlane(first, qi) + i;
        if (MK_CONV_N == 2) conv_pair(F, it); else conv_item(F, it);
    }
}
__device__ __forceinline__ void gemm_done(Frame& F, int gd_word) { if (F.tid == 0) (void)__hip_atomic_fetch_add(F.ctl + gd_word, 1u, RLX_AGENT); }
__device__ __forceinline__ void p0_prologue(Frame& F) {
    const int gw = F.bx * NWAVES + F.wave, NGW = F.G * NWAVES;
    constexpr int I_IN = 32 * (7168 / 32), I_G8 = 16 * (DIN / 32), I_A = 16 * 64, I_O = 16 * 64, I_P = 4 * 2 * 16;
    constexpr int NITEMS = I_IN + I_G8 + I_A + I_O + I_P;
    for (int it = gw; it < NITEMS; it += NGW) {
        int r = it;
        if (r < I_IN) { const int kb = r / (7168 / 32), nb = r % (7168 / 32); if (!MK_ALL_FP8) transpose_item(F_w_in, DIN, F_Win_t, 2048, 64 * kb, 32 * nb, vrow_in(32 * nb), F.lane); continue; } r -= I_IN;
        if (r < I_G8) { const int kb = r / (DIN / 32), nb = r % (DIN / 32), n0 = 32 * nb; if (MK_ALL_FP8 || (n0 >= 2048 && n0 < 6144) || n0 >= 7168) transpose_item_q8<true>(F_w_in, DIN, F_Win8, 2048, 128 * kb, n0, vrow_in(n0), QS(2), F.lane); continue; } r -= I_G8;
        if (r < I_A) { const int kb = r / 64, nb = r % 64; transpose_item_q8<false>(F_w_a_out, 2048, F_Wa8, 2048, 128 * kb, 32 * nb, 32 * nb, P3_WA_SCALE, F.lane); continue; } r -= I_A;
        if (r < I_O) { const int kb = r / 64, nb = r % 64; transpose_item_q8<false>(F_w_o, 2048, F_Wo8, 2048, 128 * kb, 32 * nb, 32 * nb, P4_WO_SCALE, F.lane); continue; } r -= I_O;
        { const int g = r / 32, q = r % 32, kb = q / 16, nb = q % 16; transpose_item_q8<false>(F_pool_w + (size_t)g * 256 * 512, 512, F_Wp8, 2048, 128 * kb, 32 * nb, g * 512 + 32 * nb, P3_WP_SCALE, F.lane); }
    }
    for (int idx = F.bx * NTHREADS + F.tid; idx < 32 * 2048; idx += F.G * NTHREADS) { const int n = idx >> 11, k = idx & 2047; const float w = F_router_w[(size_t)k * 32 + n];
        const unsigned hi = cvt_pk_bf16(w, 0.f) & 0xffffu; const float rem = w - __uint_as_float(hi << 16); F_RWhi[idx] = (bf16_t)hi; F_RWlo[idx] = (bf16_t)(cvt_pk_bf16(rem, 0.f) & 0xffffu); }
    for (int m = gw; m < T + NMETA; m += NGW) {
        if (m < T) ln_row_to_bf16(F_x + (size_t)m * D, F_ln_in_g, F_ln_in_b, F_H0 + (size_t)m * D, F_H0Q + (size_t)m * D, QS(0), F.lane);
        else ln_row_to_bf16(F_meta + (size_t)(m - T) * D, F_ln_in_g, F_ln_in_b, F_H0meta + (size_t)(m - T) * D, F_H0metaQ + (size_t)(m - T) * D, QS(0), F.lane);
    }
}

__device__ __forceinline__ void p1_meta(Frame& F) {
    const float deq = 1.0f / (QS(0) * QS(2));
    for (int task = F.bx; task < 192; task += F.G) {
    const int fr = F.lane & 15, fq = F.lane >> 4, w = F.wave;
    const bool is_cu = task < 128;
    const int col = is_cu ? 16 * task : 16 * (task - 128);
    const int vr = is_cu ? 2048 + 256 * (col >> 7) + (col & 127) + fr : 6144 + col + fr;
    const unsigned char* a_p = F_H0metaQ + (size_t)fr * 2048 + 16 * fq + 256 * w;
    const unsigned char* b0 = F_Win8 + (size_t)vr * 2048 + 16 * fq + 256 * w; const unsigned char* b1 = b0 + (size_t)128 * 2048;
    i32x4v av[4], x0[4], x1[4];
#pragma unroll
    for (int kk = 0; kk < 4; ++kk) { av[kk] = *(const i32x4v*)(a_p + 64 * kk); x0[kk] = *(const i32x4v*)(b0 + 64 * kk); x1[kk] = is_cu ? *(const i32x4v*)(b1 + 64 * kk) : x0[kk]; }
    i32x4v acc0 = {0, 0, 0, 0}, acc1 = {0, 0, 0, 0};
#pragma unroll
    for (int kk = 0; kk < 4; ++kk) { acc0 = __builtin_amdgcn_mfma_i32_16x16x64_i8(av[kk], x0[kk], acc0, 0, 0, 0); acc1 = __builtin_amdgcn_mfma_i32_16x16x64_i8(av[kk], x1[kk], acc1, 0, 0, 0); }
    LAS i32x4v* part = (LAS i32x4v*)(F.lds + L_STAGE);
    part[(w * 2 + 0) * 64 + F.lane] = acc0; part[(w * 2 + 1) * 64 + F.lane] = acc1;
    __syncthreads();
    if (w == 0) {
        i32x4v s0 = {0, 0, 0, 0}, s1 = {0, 0, 0, 0};
#pragma unroll
        for (int ww = 0; ww < 8; ++ww) { s0 += part[(ww * 2 + 0) * 64 + F.lane]; s1 += part[(ww * 2 + 1) * 64 + F.lane]; }
        if (is_cu) {
#pragma unroll
            for (int i = 0; i < 4; ++i) F_CUmeta[(size_t)(4 * fq + i) * 2048 + col + fr] = (bf16_t)(cvt_pk_bf16((float)s0[i] * (float)s1[i] * (deq * deq), 0.f) & 0xffffu);
        } else {
#pragma unroll
            for (int i = 0; i < 4; ++i) F_Vmeta[(size_t)(4 * fq + i) * 1024 + col + fr] = (bf16_t)(cvt_pk_bf16((float)s0[i] * deq, 0.f) & 0xffffu);
        }
    }
    __syncthreads();
    }
}

__device__ __forceinline__ void p2_elementwise(Frame& F) {
    const int gw = F.bx * NWAVES + F.wave, NGW = F.G * NWAVES, lane = F.lane;
    constexpr int RCH = 32;
    for (int task = gw; task < (T / RCH) * 8; task += NGW) {
        const int sl = task & 7, t0 = (task >> 3) * RCH, s0 = t0 & (SEQ - 1);
        if (sl < 4) {
            const int col = sl * 512 + 8 * lane;
            const bf16_t* cu = F_CU + (size_t)t0 * 2048 + col; const unsigned char* bg = F_BG8 + (size_t)t0 * 2048 + col; unsigned char* ap = F_AP8 + (size_t)t0 * APITCH + col; const float binv = P3_A_SCALE / QS(35);
            const f32x4 w0a = *(const f32x4*)(F_conv_w + col), w0b = *(const f32x4*)(F_conv_w + col + 4), w1a = *(const f32x4*)(F_conv_w + 2048 + col), w1b = *(const f32x4*)(F_conv_w + 2048 + col + 4),
                        w2a = *(const f32x4*)(F_conv_w + 4096 + col), w2b = *(const f32x4*)(F_conv_w + 4096 + col + 4);
            const u32x4 p2 = (s0 > 0) ? *(const u32x4*)(cu - 2 * 2048) : *(const u32x4*)(F_CUmeta + (size_t)14 * 2048 + col);
            const u32x4 p1 = (s0 > 0) ? *(const u32x4*)(cu - 1 * 2048) : *(const u32x4*)(F_CUmeta + (size_t)15 * 2048 + col);
            f32x4 x0a, x0b, x1a, x1b; unpack8(p2, x0a, x0b); unpack8(p1, x1a, x1b);
#pragma unroll 1
            for (int r0 = 0; r0 < RCH; r0 += 8) {
                u32x4 cw[8]; u32x2 bw[8];
#pragma unroll
                for (int i = 0; i < 8; ++i) { cw[i] = __builtin_nontemporal_load((const u32x4*)(cu + (size_t)(r0 + i) * 2048)); bw[i] = __builtin_nontemporal_load((const u32x2*)(bg + (size_t)(r0 + i) * 2048)); }
#pragma unroll
                for (int i = 0; i < 8; ++i) { f32x4 x2a, x2b; unpack8(cw[i], x2a, x2b); const f32x4 ba = s8x4_to_f(bw[i].x) * binv, bb = s8x4_to_f(bw[i].y) * binv;
                    const f32x4 ya = ba * (w0a * x0a + w1a * x1a + w2a * x2a), yb = bb * (w0b * x0b + w1b * x1b + w2b * x2b);
                    u32x2 o8; o8.x = pack4_fp8(clamp448(ya[0]), clamp448(ya[1]), clamp448(ya[2]), clamp448(ya[3])); o8.y = pack4_fp8(clamp448(yb[0]), clamp448(yb[1]), clamp448(yb[2]), clamp448(yb[3]));
                    *(u32x2*)(ap + (size_t)(r0 + i) * APITCH) = o8;
                    x0a = x1a; x0b = x1b; x1a = x2a; x1b = x2b; }
            }
        } else {
            const int g = sl - 4, win = 2 << g, col = g * 256 + 4 * lane; const float inv = 1.0f / (float)win;
            const bf16_t* vp = F_V + (size_t)t0 * 1024 + col; const bf16_t* vm = F_Vmeta + (size_t)16 * 1024 + col; unsigned char* ap = F_AP8 + (size_t)t0 * APITCH + 2048 + col;
#define VROW(q) ((s0 + (q) >= 0) ? *(const u32x2*)(vp + (ptrdiff_t)(q) * 1024) : *(const u32x2*)(vm + (ptrdiff_t)(s0 + (q)) * 1024))
            f32x4 sum = {0.f, 0.f, 0.f, 0.f};
            for (int i = 1; i < win; ++i) { const u32x2 w = VROW(-i); sum += (f32x4){bf_lo(w.x), bf_hi(w.x), bf_lo(w.y), bf_hi(w.y)}; }
#pragma unroll 1
            for (int r0 = 0; r0 < RCH; r0 += 8) {
                u32x2 nw[8], ow[8];
#pragma unroll
                for (int i = 0; i < 8; ++i) { nw[i] = *(const u32x2*)(vp + (size_t)(r0 + i) * 1024); ow[i] = VROW(r0 + i - win + 1); }
#pragma unroll
                for (int i = 0; i < 8; ++i) { const f32x4 v = {bf_lo(nw[i].x), bf_hi(nw[i].x), bf_lo(nw[i].y), bf_hi(nw[i].y)}, o = {bf_lo(ow[i].x), bf_hi(ow[i].x), bf_lo(ow[i].y), bf_hi(ow[i].y)};
                    sum += v; const f32x4 p = (sum * inv - v) * P3_A_SCALE; sum -= o;
                    *(unsigned*)(ap + (size_t)(r0 + i) * APITCH) = pack4_fp8(clamp448(p.x), clamp448(p.y), clamp448(p.z), clamp448(p.w)); }
            }
#undef VROW
        }
    }
}

__device__ __forceinline__ void p5_router(Frame& F) {
    LAS unsigned char* lds = F.lds;
    LAS int* sel_e = (LAS int*)(lds + L_SEL_E); LAS int* sel_r = (LAS int*)(lds + L_SEL_R); LAS float* sel_w = (LAS float*)(lds + L_SEL_W);
    LAS int* hist = (LAS int*)(lds + L_HIST); LAS int* gbase = (LAS int*)(lds + L_BASE);
    LAS float* part = (LAS float*)(lds + L_PART);
    const int lane = F.lane, w = F.wave, fr = lane & 15, fq = lane >> 4;
    const float qs1 = QS(1);
    for (int blk = F.bx; blk < T / 64; blk += F.G) {
        if (F.tid < 32) hist[F.tid] = 0;
        __syncthreads();
        u32x2 hc[2][8], mc[2][8];
#pragma unroll
        for (int q = 0; q < 2; ++q) { const size_t t = (size_t)blk * 64 + 2 * w + q; const GAS u32x2* hr = (const GAS u32x2*)(F_H0 + t * D) + lane; const GAS u32x2* mr = (const GAS u32x2*)(F_MIX + t * D) + lane;
#pragma unroll
            for (int j = 0; j < 8; ++j) { hc[q][j] = __builtin_nontemporal_load(hr + 64 * j); mc[q][j] = __builtin_nontemporal_load(mr + 64 * j); } }
#pragma unroll 1
        for (int p = 0; p < 4; ++p) {
#pragma unroll
            for (int q = 0; q < 2; ++q) {
                const int tl = 2 * w + q; const size_t t = (size_t)blk * 64 + 16 * p + tl;
                f32x4 v[8]; float s = 0.f;
#pragma unroll
                for (int j = 0; j < 8; ++j) { const u32x2 hw = hc[q][j], mw = mc[q][j];
                    v[j] = (f32x4){bf_lo(hw.x), bf_hi(hw.x), bf_lo(hw.y), bf_hi(hw.y)} * DN_ALPHA + (f32x4){bf_lo(mw.x), bf_hi(mw.x), bf_lo(mw.y), bf_hi(mw.y)}; s += (v[j].x + v[j].y) + (v[j].z + v[j].w); }
                const float mean = wave_sum(s) * (1.f / D); float s2 = 0.f;
#pragma unroll
                for (int j = 0; j < 8; ++j) { v[j] = v[j] - mean; s2 += (v[j].x * v[j].x + v[j].y * v[j].y) + (v[j].z * v[j].z + v[j].w * v[j].w); }
                const float rstd = 1.f / sqrtf(wave_sum(s2) * (1.f / D) + LN_EPS);
                GAS u32x2* o8 = (GAS u32x2*)(F_H1 + t * D) + lane;
#pragma unroll
                for (int j = 0; j < 8; ++j) { const f32x4 gg = *((const GAS f32x4*)F_ln1_g + lane + 64 * j), bb = *((const GAS f32x4*)F_ln1_b + lane + 64 * j); const f32x4 y = v[j] * rstd * gg + bb;
                    u32x2 hi; hi.x = cvt_pk_bf16(y.x, y.y); hi.y = cvt_pk_bf16(y.z, y.w); o8[64 * j] = hi;
                    *((GAS unsigned*)(F_H1Q + t * D) + lane + 64 * j) = pack4_i8(y.x * qs1, y.y * qs1, y.z * qs1, y.w * qs1);
                    const f32x4 rem = {y.x - bf_lo(hi.x), y.y - bf_hi(hi.x), y.z - bf_lo(hi.y), y.w - bf_hi(hi.y)};
                    u32x2 lo; lo.x = cvt_pk_bf16(rem.x, rem.y); lo.y = cvt_pk_bf16(rem.z, rem.w);
                    const int boff = tl * RPITCH + (4 * lane + 256 * j) * 2;
                    *(LAS u32x2*)(lds + L_AHI + boff) = hi; *(LAS u32x2*)(lds + L_ALO + boff) = lo; }
            }
            __syncthreads();
            f32x4 acc[2] = {{0.f, 0.f, 0.f, 0.f}, {0.f, 0.f, 0.f, 0.f}};
#pragma unroll 2
            for (int ks = 0; ks < 8; ++ks) { const int k0 = 256 * w + 32 * ks + 8 * fq;
                const bf16x8 ah = *(const LAS bf16x8*)(lds + L_AHI + fr * RPITCH + k0 * 2), al = *(const LAS bf16x8*)(lds + L_ALO + fr * RPITCH + k0 * 2);
#pragma unroll
                for (int nb = 0; nb < 2; ++nb) { const bf16x8 bh = *(const bf16x8*)(F_RWhi + (size_t)(16 * nb + fr) * 2048 + k0), bl = *(const bf16x8*)(F_RWlo + (size_t)(16 * nb + fr) * 2048 + k0);
                    acc[nb] = __builtin_amdgcn_mfma_f32_16x16x32_bf16(ah, bh, acc[nb], 0, 0, 0);
                    acc[nb] = __builtin_amdgcn_mfma_f32_16x16x32_bf16(al, bh, acc[nb], 0, 0, 0);
                    acc[nb] = __builtin_amdgcn_mfma_f32_16x16x32_bf16(ah, bl, acc[nb], 0, 0, 0); } }
            if (p < 3) {
#pragma unroll
                for (int q = 0; q < 2; ++q) { const size_t t = (size_t)blk * 64 + 16 * (p + 1) + 2 * w + q; const GAS u32x2* hr = (const GAS u32x2*)(F_H0 + t * D) + lane; const GAS u32x2* mr = (const GAS u32x2*)(F_MIX + t * D) + lane;
#pragma unroll
                    for (int j = 0; j < 8; ++j) { hc[q][j] = __builtin_nontemporal_load(hr + 64 * j); mc[q][j] = __builtin_nontemporal_load(mr + 64 * j); } } }
#pragma unroll
            for (int nb = 0; nb < 2; ++nb)
#pragma unroll
                for (int i = 0; i < 4; ++i) part[(w * 16 + 4 * fq + i) * 32 + 16 * nb + fr] = acc[nb][i];
            __syncthreads();
            { const int tk = F.tid >> 5, e = F.tid & 31; float x = F_router_b[e];
#pragma unroll
              for (int ww = 0; ww < 8; ++ww) x += part[(ww * 16 + tk) * 32 + e];
              float vals[4]; int idxs[4]; float cur = x;
#pragma unroll
              for (int r = 0; r < 4; ++r) { float bv = cur; int bi = e;
#pragma unroll
                  for (int o = 16; o >= 1; o >>= 1) { const float ov = __shfl_xor(bv, o); const int oi = __shfl_xor(bi, o); if (ov > bv || (ov == bv && oi < bi)) { bv = ov; bi = oi; } }
                  vals[r] = bv; idxs[r] = bi; if (e == bi) cur = -3.0e38f; }
              const float e1 = __expf(vals[1] - vals[0]), e2 = __expf(vals[2] - vals[0]), e3 = __expf(vals[3] - vals[0]); const float inv = 1.0f / (1.0f + e1 + e2 + e3);
              if (e < 4) { const int se = e == 0 ? idxs[0] : e == 1 ? idxs[1] : e == 2 ? idxs[2] : idxs[3]; const float sw = (e == 0 ? 1.0f : e == 1 ? e1 : e == 2 ? e2 : e3) * inv;
                  const int rk = __hip_atomic_fetch_add(hist + se, 1, __ATOMIC_RELAXED, __HIP_MEMORY_SCOPE_WORKGROUP); const int slot = (16 * p + tk) * 4 + e; sel_e[slot] = se; sel_r[slot] = rk; sel_w[slot] = sw; } }
            __syncthreads();
        }
        if (F.tid < 32) gbase[F.tid] = (int)__hip_atomic_fetch_add(F.ctl + CW_CNT + F.tid, (unsigned)hist[F.tid], RLX_AGENT);
        __syncthreads();
        if (F.tid < 256) { const int se = sel_e[F.tid], pos = gbase[se] + sel_r[F.tid]; const int tok = blk * 64 + (F.tid >> 2);
            F_tok_list[(size_t)se * T + pos] = tok; F_wt_list[(size_t)se * T + pos] = sel_w[F.tid]; F_topk_slot[(size_t)tok * 4 + (F.tid & 3)] = se * T + pos; }
        __syncthreads();
    }
}

__device__ __forceinline__ void p8_final(Frame& F) {
    const LAS int* tbase = (const LAS int*)(F.lds + L_TBASE);
    const int gw = F.bx * NWAVES + F.wave, NGW = F.G * NWAVES, lane = F.lane;
    for (int t = gw; t < T; t += NGW) {
        size_t rows[4];
#pragma unroll
        for (int k = 0; k < 4; ++k) { const int sl = F_topk_slot[(size_t)t * 4 + k]; const int e = sl >> 14, pos = sl & (T - 1); rows[k] = (size_t)tbase[e] * 256 + pos; }
        f32x4 v[8]; float s = 0.f;
#pragma unroll
        for (int j = 0; j < 8; ++j) { const u32x2 hw = __builtin_nontemporal_load((const GAS u32x2*)(F_H1 + (size_t)t * D) + lane + 64 * j);
            f32x4 a = (f32x4){bf_lo(hw.x), bf_hi(hw.x), bf_lo(hw.y), bf_hi(hw.y)} * DN_ALPHA;
#pragma unroll
            for (int k = 0; k < 4; ++k) { const int ow = __builtin_nontemporal_load((const GAS int*)(F_OSLOT8 + rows[k] * D) + lane + 64 * j); const f32x2 lo = __builtin_amdgcn_cvt_pk_f32_fp8(ow, false), hi = __builtin_amdgcn_cvt_pk_f32_fp8(ow, true);
                a += (f32x4){lo.x, lo.y, hi.x, hi.y} * (1.0f / OS_SCALE); }
            v[j] = a; s += (a.x + a.y) + (a.z + a.w); }
        const float mean = wave_sum(s) * (1.f / D); float s2 = 0.f;
#pragma unroll
        for (int j = 0; j < 8; ++j) { v[j] = v[j] - mean; s2 += (v[j].x * v[j].x + v[j].y * v[j].y) + (v[j].z * v[j].z + v[j].w * v[j].w); }
        const float rstd = 1.f / sqrtf(wave_sum(s2) * (1.f / D) + LN_EPS);
        GAS f32x4* op = (GAS f32x4*)(F_out + (size_t)t * D) + lane;
#pragma unroll
        for (int j = 0; j < 8; ++j) { const f32x4 gg = *((const GAS f32x4*)F_ln2_g + lane + 64 * j), bb = *((const GAS f32x4*)F_ln2_b + lane + 64 * j); __builtin_nontemporal_store(v[j] * rstd * gg + bb, op + 64 * j); }
    }
}

__global__ void __launch_bounds__(NTHREADS, 2) mk_fwd(Args args) {
    extern __shared__ __attribute__((aligned(16))) unsigned char lds_raw[];
    Frame F;
    F.lds = (LAS unsigned char*)lds_raw;
    F.tid = threadIdx.x; F.lane = F.tid & 63; F.wave = __builtin_amdgcn_readfirstlane(F.tid >> 6); F.G = gridDim.x; F.bx = blockIdx.x;
    F.ws = args.ws; F.a = &args;
    F.ctl = (unsigned*)(F.ws + WS_CTL);
    volatile LAS unsigned* MISC = (volatile LAS unsigned*)(F.lds + L_MISC);
    if (F.tid < 32) MISC[F.tid] = 0u;
    { LAS float* part = (LAS float*)(F.lds + L_STAGE);
      const int so = F.wave * 64 + F.lane;
      f32x4 gv[2], bv[2], wv[33];
      gv[0] = *((const GAS f32x4*)F_ln_in_g + so); bv[0] = *((const GAS f32x4*)F_ln_in_b + so); gv[1] = *((const GAS f32x4*)F_ln1_g + so); bv[1] = *((const GAS f32x4*)F_ln1_b + so);
      wv[0] = *((const GAS f32x4*)F_w_in + so);
#pragma unroll
      for (int e = 0; e < 32; ++e) wv[1 + e] = *((const GAS f32x4*)(F_w_gate_up + (size_t)e * 2048 * 4096) + so);
#pragma unroll
      for (int q = 0; q < 2; ++q) { const float gm = wave_max(fmaxf(fmaxf(fabsf(gv[q].x), fabsf(gv[q].y)), fmaxf(fabsf(gv[q].z), fabsf(gv[q].w)))), bm = wave_max(fmaxf(fmaxf(fabsf(bv[q].x), fabsf(bv[q].y)), fmaxf(fabsf(bv[q].z), fabsf(bv[q].w))));
          if (F.lane == 0) { part[F.wave * 37 + 2 * q] = gm; part[F.wave * 37 + 2 * q + 1] = bm; } }
#pragma unroll
      for (int i = 0; i < 33; ++i) { const float ss = wave_sum((wv[i].x * wv[i].x + wv[i].y * wv[i].y) + (wv[i].z * wv[i].z + wv[i].w * wv[i].w)); if (F.lane == 0) part[F.wave * 37 + 4 + i] = ss; }
      __syncthreads();
      LAS float* qs = (LAS float*)(F.lds + L_QS);
      if (F.tid < 2) { float gm = 0.f, bm = 0.f;
#pragma unroll
          for (int w8 = 0; w8 < 8; ++w8) { gm = fmaxf(gm, part[w8 * 37 + 2 * F.tid]); bm = fmaxf(bm, part[w8 * 37 + 2 * F.tid + 1]); }
          qs[F.tid] = 127.0f / (Q_ACT_SIGMAS * gm + bm + 1e-20f); }
      else if (F.tid == 35) { float gm = 0.f, bm = 0.f, ss = 0.f;
#pragma unroll
          for (int w8 = 0; w8 < 8; ++w8) { gm = fmaxf(gm, part[w8 * 37 + 0]); bm = fmaxf(bm, part[w8 * 37 + 1]); ss += part[w8 * 37 + 4]; }
          qs[35] = 127.0f / (6.0f * 45.254834f * sqrtf(ss * (1.0f / 2048.0f)) * (gm + bm) + 1e-30f); }
      else if (F.tid < 35) { float ss = 0.f;
#pragma unroll
          for (int w8 = 0; w8 < 8; ++w8) ss += part[w8 * 37 + 4 + (F.tid - 2)];
          qs[F.tid] = 127.0f / (Q_W_SIGMAS * sqrtf(ss * (1.0f / 2048.0f)) + 1e-30f); } }
    __syncthreads();
    const int lo = args.ph_lo, hi = args.ph_hi;
    XcdBarrier bar; bar.bar = (unsigned*)(F.ctl + CW_BAR); bar.x = 0; bar.st = nullptr;
    if (hi - lo > 1) bar = xcd_barrier_post((unsigned*)(F.ctl + CW_BAR), MISC + 8);
#ifndef MK_PHMASK
#define MK_PHMASK 0x1ff
#endif
#ifndef MK_REP_MASK
#define MK_REP_MASK 0
#endif
#define IN(k) (((MK_PHMASK >> (k)) & 1) && lo <= (k) && (k) < hi)
#define SEAM(k) do { if (IN(k) && IN((k) + 1)) xcd_barrier(bar); } while (0)

#if MK_CONVPROBE > 0
    if (lo == 0) { if (F.bx >= 256 - MK_CONVPROBE) conv_worker(F, -1, 0, CW_CONV + 512); if (hi - lo > 1) xcd_barrier(bar); }
#endif
    if (IN(0)) { p0_prologue(F); } SEAM(0);
    const bool split = (F.G == 256);
    if (IN(1)) { constexpr int GG = MK_GG1; const int gg = split ? GG : F.G;
        if (F.bx < gg) { p1_meta(F);
            ProbInProj8 Q; Q.G = gg; Q.c = F.bx; Q.A8 = F_H0Q; Q.B8 = F_Win8; Q.BG8 = F_BG8; Q.CU = F_CU; Q.V = F_V; Q.G8 = F_G8; Q.deq = 1.0f / (QS(0) * QS(2)); Q.bgq = QS(35);
            pg8::gemm_phase(F.lds + L_STAGE, Q); gemm_done(F, CW_GDONE + 32 * 1); }
        if (MK_CONVMASK & 2) conv_worker(F, CW_GDONE + 32 * 1, gg, MK_CONVWRAP ? CW_CONV + 512 : CW_CONV); } SEAM(1);
    if (IN(2)) { p2_elementwise(F); } SEAM(2);
    if (IN(3)) { constexpr int GG = MK_GG3; const int gg = split ? GG : F.G;
        if (F.bx < gg) { ProbMix P; P.G = gg; P.c = F.bx; P.AP = F_AP8; P.Wp_t = F_Wp8; P.Wa_t = F_Wa8; P.G8 = F_G8; P.pool_scale = F_pool_scale; P.YB = F_YB; P.MERGED = F_MERGED8;
            pg8::gemm_phase(F.lds + L_STAGE, P); gemm_done(F, CW_GDONE + 32 * 3); }
        if (MK_CONVMASK & 8) conv_worker(F, CW_GDONE + 32 * 3, gg, MK_CONVWRAP ? CW_CONV + 512 : CW_CONV); } SEAM(3);
    if (IN(4)) { constexpr int GG = MK_GG4; const int gg = split ? GG : F.G;
        if (F.bx < gg) { ProbWo P; P.G = gg; P.c = F.bx; P.A = F_MERGED8; P.Bt = F_Wo8; P.MIX = F_MIX;
            pg8::gemm_phase(F.lds + L_STAGE, P); gemm_done(F, CW_GDONE + 32 * 4); }
        if (MK_CONVMASK & 16) conv_worker(F, CW_GDONE + 32 * 4, gg, MK_CONVWRAP ? CW_CONV + 512 : CW_CONV); } SEAM(4);
    if (IN(5)) { conv_cleanup(F); p5_router(F); } SEAM(5);
    if (IN(6)) {
        const int NT = moe_build_tables(F);
        ProbGateUp P; P.G = F.G; P.c = F.bx; P.NT = NT; P.lds = F.lds; P.H1Q = F_H1Q; P.Wgu8 = F_Wgu8; P.b_gate_up = F_b_gate_up; P.ACT8 = F_ACT8;
        { LAS int* rows = (LAS int*)(F.lds + L_ROWS); const LAS int* cntl = (const LAS int*)(F.lds + L_CNT); const LAS int* tbase = (const LAS int*)(F.lds + L_TBASE);
          ProbGateUp::U u;
          for (int i = 0; i < 18 && P.next(i, u); ++i) { if (F.tid < 256) { const int idx = (u.rt - tbase[u.e]) * 256 + F.tid; rows[i * 256 + F.tid] = idx < cntl[u.e] ? F_tok_list[(size_t)u.e * T + idx] : 0; } }
          VM_WAIT(); __syncthreads(); }
        pg8::gemm_phase(F.lds + L_STAGE, P); } SEAM(6);
    if (IN(7)) {
        const int NT = moe_build_tables(F);
        ProbDown P; P.G = F.G; P.c = F.bx; P.NT = NT; P.lds = F.lds; P.ACT8 = F_ACT8; P.Wd8 = F_Wd8; P.b_down = F_b_down; P.wt_list = F_wt_list; P.OSLOT8 = F_OSLOT8;
        pg8::gemm_phase(F.lds + L_STAGE, P); } SEAM(7);
    if (IN(8)) { (void)moe_build_tables(F); p8_final(F); }
#undef IN
#undef SEAM
}

extern "C" void kernel_launch(void* const* d_in, const int* in_sizes, int n_in, void* d_out, int out_size, void* d_ws, size_t ws_size, hipStream_t stream) {
    static int grid = 0;
    if (grid == 0) {
        if (n_in != 20 || in_sizes[0] != T * D || out_size != T * D || ws_size < WS_END) { fprintf(stderr, "kernel_launch: unexpected shapes (n_in %d, in0 %d, out %d, ws %zu); nothing launched\n", n_in, n_in > 0 ? in_sizes[0] : -1, out_size, ws_size); grid = -1; return; }
        int dev = 0, cus = 0, per_cu = 0;
        if (hipGetDevice(&dev) != hipSuccess || hipDeviceGetAttribute(&cus, hipDeviceAttributeMultiprocessorCount, dev) != hipSuccess) { fprintf(stderr, "kernel_launch: device query failed\n"); grid = -1; return; }
        if (hipFuncSetAttribute((const void*)mk_fwd, hipFuncAttributeMaxDynamicSharedMemorySize, LDS_BYTES) != hipSuccess) { fprintf(stderr, "kernel_launch: hipFuncSetAttribute failed\n"); grid = -1; return; }
        if (hipOccupancyMaxActiveBlocksPerMultiprocessor(&per_cu, (const void*)mk_fwd, NTHREADS, LDS_BYTES) != hipSuccess || per_cu < 1) fprintf(stderr, "kernel_launch: note: occupancy query reports %d workgroups per CU\n", per_cu);
        (void)hipGetLastError();
        grid = cus;
    }
    if (grid < 0) return;
    if (hipMemsetAsync((char*)d_ws + WS_CTL, 0, CTL_ZERO_BYTES, stream) != hipSuccess) { fprintf(stderr, "kernel_launch: memset failed\n"); return; }
    Args a{};
    for (int i = 0; i < 20; ++i) a.in[i] = (const float*)d_in[i];
    a.out = (float*)d_out; a.ws = (unsigned char*)d_ws;
#if MK_N_LAUNCHES == 1
    a.ph_lo = 0; a.ph_hi = NPHASE;
    hipLaunchKernelGGL(mk_fwd, dim3(grid), dim3(NTHREADS), LDS_BYTES, stream, a);
#else
    for (int p = 0; p < NPHASE; ++p) { a.ph_lo = p; a.ph_hi = p + 1; const int reps = ((MK_REP_MASK >> p) & 1) ? 2 : 1;
        for (int r = 0; r < reps; ++r) { if (r > 0 && p == 5) (void)hipMemsetAsync((char*)d_ws + WS_CTL + CW_CNT * 4, 0, 128, stream);
            hipLaunchKernelGGL(mk_fwd, dim3(grid), dim3(NTHREADS), LDS_BYTES, stream, a); } }
#endif
    const hipError_t le = hipPeekAtLastError();
    if (le != hipSuccess) fprintf(stderr, "kernel_launch: launch failed: %s\n", hipGetErrorName(le));
}
```

```cpp
#include <hip/hip_runtime.h>
#include <cstdio>
#include <cstdint>

#ifndef MK_N_LAUNCHES
#define MK_N_LAUNCHES 1
#endif

#ifndef MK_P1_KREP
#define MK_P1_KREP 1
#endif
#ifndef MK_P4_KREP
#define MK_P4_KREP 1
#endif
#ifndef MK_P6_EPIREP
#define MK_P6_EPIREP 1
#endif
#ifndef MK_P7_EPIREP
#define MK_P7_EPIREP 1
#endif
#ifndef MK_ALIGN8
#define MK_ALIGN8 true
#endif
#ifndef MK_B_NT
#define MK_B_NT false
#endif
#ifndef MK_P6_KREP
#define MK_P6_KREP 1
#endif
#ifndef MK_P1_EPIREP
#define MK_P1_EPIREP 1
#endif
#define GAS __attribute__((address_space(1)))
#define LAS __attribute__((address_space(3)))
typedef unsigned short bf16_t;
typedef short bf16x8 __attribute__((ext_vector_type(8)));
typedef float f32x4 __attribute__((ext_vector_type(4)));
typedef float f32x2 __attribute__((ext_vector_type(2)));
typedef unsigned u32x4 __attribute__((ext_vector_type(4)));
typedef unsigned u32x2 __attribute__((ext_vector_type(2)));
typedef int i32x4v __attribute__((ext_vector_type(4)));
typedef int i32x8v __attribute__((ext_vector_type(8)));

constexpr int NB = 4, SEQ = 4096, D = 2048, T = NB * SEQ, NMETA = 16;
constexpr int DIN = 11264, NE = 32, TOPK = 4;
constexpr float LN_EPS = 1e-5f, SW_LIMIT = 7.0f, SW_ALPHA = 1.702f, DN_ALPHA = 1.189207115002721f;
constexpr int NPHASE = 9;
constexpr int NWAVES = 8, NTHREADS = 512;
constexpr int MAXTILES = 288;
constexpr int APITCH = 3072;

constexpr size_t MiB = (size_t)1 << 20;
constexpr size_t WS_CTL = 0, CTL_ZERO_BYTES = 64 * 1024;
constexpr size_t WS_WIN_T = 2 * MiB;
constexpr size_t WS_WA_T = 46 * MiB;
constexpr size_t WS_WO_T = 54 * MiB;
constexpr size_t WS_WP_T = 62 * MiB;
constexpr size_t WS_RW = 70 * MiB;
constexpr size_t WS_META = 71 * MiB;
constexpr size_t WS_WGU_T = 72 * MiB;
constexpr size_t WS_WD_T = 584 * MiB;
constexpr size_t WS_H1Q = 712 * MiB;
constexpr size_t WS_H0Q = 744 * MiB;
constexpr size_t WS_WIN8 = 776 * MiB;
constexpr size_t WS_H0 = 840 * MiB;
constexpr size_t WS_BG = 904 * MiB;
constexpr size_t WS_CU = 968 * MiB;
constexpr size_t WS_V = 1032 * MiB;
constexpr size_t WS_G = 1064 * MiB;
constexpr size_t WS_AP = 1192 * MiB;
constexpr size_t WS_YB = 1288 * MiB;
constexpr size_t WS_MERGED = 1352 * MiB;
constexpr size_t WS_Z = 1416 * MiB;
constexpr size_t WS_H1 = 1544 * MiB;
constexpr size_t WS_ROUTE = 1608 * MiB;
constexpr size_t WS_ACT = 1616 * MiB;
constexpr size_t WS_OSLOT = 1904 * MiB;
constexpr size_t WS_END = 2192 * MiB;
constexpr int CW_TMO = 0, CW_CNT = 64, CW_GDONE = 256, CW_CONV = 1024, CW_BAR = 4096;
constexpr float P4_M_SCALE = 16.f, P4_WO_SCALE = 512.f;
constexpr float P3_A_SCALE = 8.f, P3_WA_SCALE = 512.f, P3_WP_SCALE = 128.f;
constexpr float W_SCALE_GU = 256.f, W_SCALE_D = 512.f, H1_SCALE = 16.f, ACT_SCALE = 4.f, H0_SCALE = 16.f, W_SCALE_IN = 256.f, OS_SCALE = 32.f;
constexpr float Q_ACT_SIGMAS = 5.0f, Q_W_SIGMAS = 5.5f;
#ifndef MK_ALL_FP8
#define MK_CONV_N 2
#define MK_CONVWRAP 0
#define MK_CONVMASK 0x1a
#define MK_CONVPROBE 0
#define MK_EPI_PF true
#define MK_ZEROC 1
#define MK_ZC_DENSE false
#define MK_ZC_MOE true
#define MK_GG1 208
#define MK_GG3 176
#define MK_GG4 176
#define MK_ALL_FP8 1
#endif
constexpr int NT_BF = MK_ALL_FP8 ? 0 : 12;

constexpr int LDS_BYTES = 159744;
constexpr int L_STAGE = 0;
constexpr int L_ROWS = 131072;
constexpr int L_TILE_E = L_ROWS + 18 * 1024;
constexpr int L_CNT = L_TILE_E + MAXTILES * 4;
constexpr int L_TBASE = L_CNT + 128;
constexpr int L_EPI = L_TBASE + 256;
constexpr int L_MISC = 155648;
constexpr int L_QS = L_MISC + 128;
constexpr int RPITCH = 4112;
constexpr int L_AHI = 0, L_ALO = 16 * RPITCH, L_PART = 2 * 16 * RPITCH;
constexpr int L_SEL_E = L_PART + 16384, L_SEL_R = L_SEL_E + 1024, L_SEL_W = L_SEL_R + 1024, L_HIST = L_SEL_W + 1024, L_BASE = L_HIST + 128;
static_assert(L_EPI % 16 == 0 && L_EPI + 4096 <= L_MISC && L_BASE + 128 <= L_MISC && L_TBASE + 256 <= L_MISC && L_QS + 256 <= LDS_BYTES, "LDS map");

#define RLX_AGENT __ATOMIC_RELAXED, __HIP_MEMORY_SCOPE_AGENT
#define LDS_WAIT() asm volatile("s_waitcnt lgkmcnt(0)" ::: "memory")
#define VM_WAIT() asm volatile("s_waitcnt vmcnt(0)" ::: "memory")

__device__ __forceinline__ unsigned cvt_pk_bf16(float lo, float hi) { unsigned r; asm volatile("v_cvt_pk_bf16_f32 %0, %1, %2" : "=v"(r) : "v"(lo), "v"(hi)); return r; }
__device__ __forceinline__ float bf_lo(unsigned w) { return __uint_as_float(w << 16); }
__device__ __forceinline__ float bf_hi(unsigned w) { return __uint_as_float(w & 0xffff0000u); }
__device__ __forceinline__ u32x4 pack8(const f32x4 a, const f32x4 b) { u32x4 w; w.x = cvt_pk_bf16(a[0], a[1]); w.y = cvt_pk_bf16(a[2], a[3]); w.z = cvt_pk_bf16(b[0], b[1]); w.w = cvt_pk_bf16(b[2], b[3]); return w; }
__device__ __forceinline__ void unpack8(const u32x4 w, f32x4& a, f32x4& b) { a = (f32x4){bf_lo(w.x), bf_hi(w.x), bf_lo(w.y), bf_hi(w.y)}; b = (f32x4){bf_lo(w.z), bf_hi(w.z), bf_lo(w.w), bf_hi(w.w)}; }
__device__ __forceinline__ float clamp448(float x) { return __builtin_fminf(__builtin_fmaxf(x, -448.f), 448.f); }
__device__ __forceinline__ unsigned pack4_fp8(float a, float b, float c, float d) { int r = 0; r = __builtin_amdgcn_cvt_pk_fp8_f32(a, b, r, false); r = __builtin_amdgcn_cvt_pk_fp8_f32(c, d, r, true); return (unsigned)r; }
__device__ __forceinline__ unsigned pack4_i8(float a, float b, float c, float d) {
    unsigned r = 0;
    r = __builtin_amdgcn_cvt_pk_u8_f32(__builtin_amdgcn_fmed3f(__builtin_rintf(a) + 128.0f, 1.0f, 255.0f), 0, r); r = __builtin_amdgcn_cvt_pk_u8_f32(__builtin_amdgcn_fmed3f(__builtin_rintf(b) + 128.0f, 1.0f, 255.0f), 1, r);
    r = __builtin_amdgcn_cvt_pk_u8_f32(__builtin_amdgcn_fmed3f(__builtin_rintf(c) + 128.0f, 1.0f, 255.0f), 2, r); r = __builtin_amdgcn_cvt_pk_u8_f32(__builtin_amdgcn_fmed3f(__builtin_rintf(d) + 128.0f, 1.0f, 255.0f), 3, r);
    return r ^ 0x80808080u;
}
__device__ __forceinline__ unsigned pack4_u8(float a, float b, float c, float d) {
    unsigned r = 0;
    r = __builtin_amdgcn_cvt_pk_u8_f32(__builtin_amdgcn_fmed3f(__builtin_rintf(a), 1.0f, 255.0f), 0, r); r = __builtin_amdgcn_cvt_pk_u8_f32(__builtin_amdgcn_fmed3f(__builtin_rintf(b), 1.0f, 255.0f), 1, r);
    r = __builtin_amdgcn_cvt_pk_u8_f32(__builtin_amdgcn_fmed3f(__builtin_rintf(c), 1.0f, 255.0f), 2, r); r = __builtin_amdgcn_cvt_pk_u8_f32(__builtin_amdgcn_fmed3f(__builtin_rintf(d), 1.0f, 255.0f), 3, r);
    return r;
}
__device__ __forceinline__ f32x4 u8x4_to_f(unsigned w) { return (f32x4){(float)(w & 0xffu), (float)((w >> 8) & 0xffu), (float)((w >> 16) & 0xffu), (float)(w >> 24)}; }
__device__ __forceinline__ f32x4 s8x4_to_f(unsigned w) { const int i = (int)w; return (f32x4){(float)((i << 24) >> 24), (float)((i << 16) >> 24), (float)((i << 8) >> 24), (float)(i >> 24)}; }
__device__ __forceinline__ f32x4 i2f(const f32x4 a) { const i32x4v i = __builtin_bit_cast(i32x4v, a); return (f32x4){(float)i[0], (float)i[1], (float)i[2], (float)i[3]}; }
__device__ __forceinline__ float sigmoidf_fast(float x) { return __builtin_amdgcn_rcpf(1.0f + __builtin_amdgcn_exp2f(-1.4426950408889634f * x)); }
template <int CTRL> __device__ __forceinline__ float dpp_mov(float v) { return __builtin_bit_cast(float, __builtin_amdgcn_update_dpp(__builtin_bit_cast(int, v), __builtin_bit_cast(int, v), CTRL, 0xF, 0xF, true)); }
__device__ __forceinline__ float wave_sum(float v) {
    v += dpp_mov<0xB1>(v); v += dpp_mov<0x4E>(v); v += dpp_mov<0x141>(v); v += dpp_mov<0x140>(v);
    const int x = __builtin_bit_cast(int, v);
    const float r0 = __builtin_bit_cast(float, __builtin_amdgcn_readlane(x, 0)), r1 = __builtin_bit_cast(float, __builtin_amdgcn_readlane(x, 16)),
                r2 = __builtin_bit_cast(float, __builtin_amdgcn_readlane(x, 32)), r3 = __builtin_bit_cast(float, __builtin_amdgcn_readlane(x, 48));
    return (r0 + r1) + (r2 + r3);
}
__device__ __forceinline__ float wave_max(float v) {
    v = fmaxf(v, dpp_mov<0xB1>(v)); v = fmaxf(v, dpp_mov<0x4E>(v)); v = fmaxf(v, dpp_mov<0x141>(v)); v = fmaxf(v, dpp_mov<0x140>(v));
    const int x = __builtin_bit_cast(int, v);
    const float r0 = __builtin_bit_cast(float, __builtin_amdgcn_readlane(x, 0)), r1 = __builtin_bit_cast(float, __builtin_amdgcn_readlane(x, 16)),
                r2 = __builtin_bit_cast(float, __builtin_amdgcn_readlane(x, 32)), r3 = __builtin_bit_cast(float, __builtin_amdgcn_readlane(x, 48));
    return fmaxf(fmaxf(r0, r1), fmaxf(r2, r3));
}

#define XB_TMO      128
#define XB_XCNT(j)  (256  + 64 * (j))
#define XB_XSUB(j)  (1280 + 64 * (j))
#define XB_XGEN(j)  (2304 + 64 * (j))
#define XB_TOP      3328
#define XB_TOPGEN   3392
#define XCD_BAR_WORDS 3456
#define XB_SPIN_CAP (1u << 18)
__device__ __forceinline__ unsigned xb_ld(unsigned* p)              { return __hip_atomic_load(p, __ATOMIC_RELAXED, __HIP_MEMORY_SCOPE_AGENT); }
__device__ __forceinline__ unsigned xb_add(unsigned* p, unsigned v) { return __hip_atomic_fetch_add(p, v, __ATOMIC_RELAXED, __HIP_MEMORY_SCOPE_AGENT); }
__device__ __forceinline__ unsigned xb_xcc_id() { return (unsigned)__builtin_amdgcn_s_getreg((3 << 11) | 20) & 0xFu; }
#define XB_SPIN(cond, bar) do { unsigned _sp = 0; while (cond) { __builtin_amdgcn_s_sleep(1); \
    if ((++_sp & 255u) == 0u) { if (xb_ld(&(bar)[XB_TMO])) break; if (_sp > XB_SPIN_CAP) { atomicAdd(&(bar)[XB_TMO], 1u); break; } } } } while (0)
struct XcdBarrier { unsigned* bar; unsigned x; volatile LAS unsigned* st; };
__device__ __forceinline__ XcdBarrier xcd_barrier_post(unsigned* bar, volatile LAS unsigned* st) {
    XcdBarrier b; b.bar = bar; b.x = xb_xcc_id(); b.st = st;
    if (threadIdx.x == 0) (void)xb_add(&bar[XB_XCNT(b.x)], 1u);
    return b;
}
__device__ __forceinline__ void xcd_barrier_complete(unsigned* bar, unsigned x, unsigned& nloc, unsigned& nx) {
    const unsigned G = gridDim.x * gridDim.y * gridDim.z;
    unsigned sum, cnt, mine, sp = 0u;
    for (;;) {
        sum = 0u; cnt = 0u; mine = 0u;
#pragma unroll
        for (unsigned j = 0; j < 16; ++j) { const unsigned c = xb_ld(&bar[XB_XCNT(j)]); sum += c; cnt += (c > 0u) ? 1u : 0u; mine = (j == x) ? c : mine; }
        if (sum == G) break;
        __builtin_amdgcn_s_sleep(1);
        if ((++sp & 255u) == 0u) { if (xb_ld(&bar[XB_TMO])) break; if (sp > XB_SPIN_CAP) { atomicAdd(&bar[XB_TMO], 1u); break; } }
    }
    nloc = mine > 0u ? mine : 1u; nx = cnt > 0u ? cnt : 1u;
}
__device__ __forceinline__ void xcd_barrier(const XcdBarrier& b) {
    asm volatile("s_waitcnt vmcnt(0)" ::: "memory");
    __syncthreads();
    if (threadIdx.x == 0) {
        unsigned* bar = b.bar;
        __builtin_amdgcn_s_waitcnt(0);
        unsigned nloc = b.st[0], nx = b.st[1];
        if (nloc == 0u) { xcd_barrier_complete(bar, b.x, nloc, nx); b.st[0] = nloc; b.st[1] = nx; }
        const unsigned old = xb_add(&bar[XB_XSUB(b.x)], 1u);
        const unsigned gen = old / nloc;
        if (old + 1u == (gen + 1u) * nloc) {
            __builtin_amdgcn_fence(__ATOMIC_RELEASE, "agent");
            asm volatile("s_waitcnt vmcnt(0)" ::: "memory");
            const unsigned og = xb_add(&bar[XB_TOP], 1u);
            const unsigned tg = og / nx;
            if (og + 1u == (tg + 1u) * nx) xb_add(&bar[XB_TOPGEN], 1u);
            else XB_SPIN(xb_ld(&bar[XB_TOPGEN]) == tg, bar);
            __builtin_amdgcn_fence(__ATOMIC_ACQUIRE, "agent");
            xb_add(&bar[XB_XGEN(b.x)], 1u);
            asm volatile("s_waitcnt vmcnt(0)" ::: "memory");
        } else {
            XB_SPIN(xb_ld(&bar[XB_XGEN(b.x)]) == gen, bar);
            __builtin_amdgcn_fence(__ATOMIC_ACQUIRE, "agent");
            asm volatile("s_waitcnt vmcnt(0)" ::: "memory");
        }
    }
    __syncthreads();
}

namespace pg8 {
constexpr int BM = 256, BK = 64, HALF = 128, HTB = HALF * BK * 2, STAGE_BYTES = 8 * HTB, NXCD = 8, WGM = 8;
__host__ __device__ __forceinline__ int lds_byte(int r, int c) { const int st = (r >> 4) * 2 + (c >> 5), rr = r & 15, cc = c & 31, ob = rr * 64 + cc * 2; return st * 1024 + (ob ^ (((ob >> 9) & 1) << 5)); }
__host__ __device__ __forceinline__ void stage_rc(int b, int& R, int& C) { const int st = b / 1024, sb = b % 1024, swz = sb ^ (((sb >> 9) & 1) << 5); R = (st >> 1) * 16 + swz / 64; C = (st & 1) * 32 + (swz % 64) / 2; }
__host__ __device__ __forceinline__ int perm32(int rho) { const int n = rho >> 4, i = rho & 15; return 8 * (i >> 2) + 4 * n + (i & 3); }

__device__ __forceinline__ bool order_unit(int i, int G, int c, int nM, int nN, int& pm, int& pn) {
    const int nwg = nM * nN; const long L = (long)i * G + c; if (L >= nwg) return false;
    int wgid = (int)L; { const int q = nwg / NXCD, r = nwg % NXCD, xcd = wgid % NXCD, off = wgid / NXCD; wgid = (xcd < r ? xcd * (q + 1) : r * (q + 1) + (xcd - r) * q) + off; }
    const int nig = WGM * nN, gid = wgid / nig, fm = gid * WGM, gsz = (nM % WGM == 0) ? WGM : ((nM - fm) < WGM ? (nM - fm) : WGM);
    pm = fm + ((wgid % nig) % gsz); pn = (wgid % nig) / gsz; return true;
}

template <class P>
__device__ __forceinline__ void gemm_phase(LAS unsigned char* lds, const P& prob) {
    const int tid = threadIdx.x, wid = __builtin_amdgcn_readfirstlane(tid >> 6), lane = tid & 63, wr = wid >> 2, wc = wid & 3, fr = lane & 15, fq = lane >> 4;
    int R[2], C[2]; unsigned vB[2];
#pragma unroll
    for (int i = 0; i < 2; ++i) { stage_rc(tid * 16 + i * 8192, R[i], C[i]); const int Rb = (R[i] & ~31) + perm32(R[i] & 31); vB[i] = (unsigned)(Rb * P::LDB + C[i]) * 2u; }
    constexpr unsigned kstep = (unsigned)(BK * 2);
    constexpr unsigned hstepB = (unsigned)HALF * P::LDB * 2u;
    const unsigned ldsw = (unsigned)wid * 1024u;
    const int aoff = lds_byte(wr * 64 + fr, fq * 8), boff = lds_byte(wc * 32 + fr, fq * 8);
    const __amdgpu_buffer_rsrc_t rA = prob.a_rsrc(), rB = prob.b_rsrc();
#define PG8_SA(b, h) (((b) * 2 + (h)) * HTB)
#define PG8_SB(b, h) ((4 + (b) * 2 + (h)) * HTB)
#define PG8_STAGE(bufoff, rsrc, soff, voff) do { _Pragma("unroll") for (int _i = 0; _i < 2; ++_i) \
        __builtin_amdgcn_raw_ptr_buffer_load_lds(rsrc, (LAS void*)(lds + (bufoff) + ldsw + _i * 8192), 16, (int)(voff)[_i], (int)(soff), 0, 0); } while (0)
#define PG8_STAGE_B(bufoff, rsrc, soff, voff) do { _Pragma("unroll") for (int _i = 0; _i < 2; ++_i) \
        __builtin_amdgcn_raw_ptr_buffer_load_lds(rsrc, (LAS void*)(lds + (bufoff) + ldsw + _i * 8192), 16, (int)(voff)[_i], (int)(soff), 0, P::B_NT ? 2 : 0); } while (0)
#define PG8_LDA(dst, b, h) do { _Pragma("unroll") for (int m = 0; m < 4; ++m) _Pragma("unroll") for (int k = 0; k < 2; ++k) dst[m][k] = *(const LAS bf16x8*)(lds + PG8_SA(b, h) + aoff + m * 2048 + k * 1024); } while (0)
#define PG8_LDB(dst, b, h) do { _Pragma("unroll") for (int n = 0; n < 2; ++n) _Pragma("unroll") for (int k = 0; k < 2; ++k) dst[n][k] = *(const LAS bf16x8*)(lds + PG8_SB(b, h) + boff + n * 2048 + k * 1024); } while (0)
#define PG8_CAT(x) __builtin_shufflevector(__builtin_bit_cast(i32x4v, (x)[0]), __builtin_bit_cast(i32x4v, (x)[1]), 0, 1, 2, 3, 4, 5, 6, 7)
#define PG8_MMA(ai, bj, At, Bt) do { __builtin_amdgcn_s_setprio(1); \
        if constexpr (P::FP8) { _Pragma("unroll") for (int m = 0; m < 4; ++m) _Pragma("unroll") for (int n = 0; n < 2; ++n) \
            asm volatile("v_mfma_scale_f32_16x16x128_f8f6f4 %0, %1, %2, %0, %3, %3 op_sel_hi:[0,0,0]" : "+v"(acc[ai][bj][m][n]) : "v"(PG8_CAT(Bt[n])), "v"(PG8_CAT(At[m])), "v"(one_scale)); } \
        else if constexpr (P::I8) { _Pragma("unroll") for (int m = 0; m < 4; ++m) _Pragma("unroll") for (int n = 0; n < 2; ++n) _Pragma("unroll") for (int k = 0; k < 2; ++k) \
            acc[ai][bj][m][n] = __builtin_bit_cast(f32x4, __builtin_amdgcn_mfma_i32_16x16x64_i8(__builtin_bit_cast(i32x4v, Bt[n][k]), __builtin_bit_cast(i32x4v, At[m][k]), __builtin_bit_cast(i32x4v, acc[ai][bj][m][n]), 0, 0, 0)); } \
        else { _Pragma("unroll") for (int m = 0; m < 4; ++m) _Pragma("unroll") for (int n = 0; n < 2; ++n) _Pragma("unroll") for (int k = 0; k < 2; ++k) \
            acc[ai][bj][m][n] = __builtin_amdgcn_mfma_f32_16x16x32_bf16(Bt[n][k], At[m][k], acc[ai][bj][m][n], 0, 0, 0); } \
        __builtin_amdgcn_s_setprio(0); } while (0)
#define PG8_MMA0(ai, bj, At, Bt) do { __builtin_amdgcn_s_setprio(1); \
        if constexpr (P::FP8) { _Pragma("unroll") for (int m = 0; m < 4; ++m) _Pragma("unroll") for (int n = 0; n < 2; ++n) \
            asm volatile("v_mfma_scale_f32_16x16x128_f8f6f4 %0, %1, %2, 0, %3, %3 op_sel_hi:[0,0,0]" : "=&v"(acc[ai][bj][m][n]) : "v"(PG8_CAT(Bt[n])), "v"(PG8_CAT(At[m])), "v"(one_scale)); } \
        else if constexpr (P::I8) { _Pragma("unroll") for (int m = 0; m < 4; ++m) _Pragma("unroll") for (int n = 0; n < 2; ++n) { \
            acc[ai][bj][m][n] = __builtin_bit_cast(f32x4, __builtin_amdgcn_mfma_i32_16x16x64_i8(__builtin_bit_cast(i32x4v, Bt[n][0]), __builtin_bit_cast(i32x4v, At[m][0]), (i32x4v){0, 0, 0, 0}, 0, 0, 0)); \
            acc[ai][bj][m][n] = __builtin_bit_cast(f32x4, __builtin_amdgcn_mfma_i32_16x16x64_i8(__builtin_bit_cast(i32x4v, Bt[n][1]), __builtin_bit_cast(i32x4v, At[m][1]), __builtin_bit_cast(i32x4v, acc[ai][bj][m][n]), 0, 0, 0)); } } \
        else { _Pragma("unroll") for (int m = 0; m < 4; ++m) _Pragma("unroll") for (int n = 0; n < 2; ++n) { \
            acc[ai][bj][m][n] = __builtin_amdgcn_mfma_f32_16x16x32_bf16(Bt[n][0], At[m][0], (f32x4){0.f, 0.f, 0.f, 0.f}, 0, 0, 0); \
            acc[ai][bj][m][n] = __builtin_amdgcn_mfma_f32_16x16x32_bf16(Bt[n][1], At[m][1], acc[ai][bj][m][n], 0, 0, 0); } } \
        __builtin_amdgcn_s_setprio(0); } while (0)
#define PG8_WAIT_V(n) asm volatile("s_waitcnt vmcnt(" #n ")" ::: "memory")
#define PG8_WAIT_L(n) asm volatile("s_waitcnt lgkmcnt(" #n ")" ::: "memory")
#define PG8_BAR __builtin_amdgcn_s_barrier()
#define PG8_SCHED __builtin_amdgcn_sched_barrier(0)
    typename P::U cur, nxt; int ui = 0;
    if (!prob.next(0, cur)) return;
    f32x4 acc[2][2][4][2];
#pragma unroll
    for (int a = 0; a < 2; ++a)
#pragma unroll
        for (int b = 0; b < 2; ++b)
#pragma unroll
            for (int m = 0; m < 4; ++m)
#pragma unroll
                for (int n = 0; n < 2; ++n) acc[a][b][m][n] = (f32x4){0.f, 0.f, 0.f, 0.f};
    bf16x8 At[4][2], B0[2][2], B1[2][2];
    unsigned one_scale = 0x7f7f7f7fu; asm volatile("" : "+v"(one_scale));
    unsigned vA0[2], vA1[2], nA0[2], nA1[2];
    constexpr unsigned hstepA = P::GATHER ? 0u : (unsigned)HALF * P::LDA * 2u;
    if constexpr (P::GATHER) { prob.a_offs(0, cur, R, C, vA0, vA1); }
    else {
#pragma unroll
        for (int i = 0; i < 2; ++i) { vA0[i] = (unsigned)(R[i] * P::LDA + C[i]) * 2u; vA1[i] = vA0[i]; nA0[i] = vA0[i]; nA1[i] = vA0[i]; } }
    unsigned cA = prob.a_soff(cur), cB = prob.b_soff(cur);
    int nt = prob.nt(cur);
    PG8_STAGE_B(PG8_SB(0, 0), rB, cB, vB); PG8_STAGE_B(PG8_SB(0, 1), rB, cB + hstepB, vB); PG8_STAGE(PG8_SA(0, 0), rA, cA, vA0); PG8_STAGE(PG8_SA(0, 1), rA, cA + hstepA, vA1);
    if (wr == 1) PG8_BAR;
    PG8_WAIT_V(2); PG8_BAR;
    PG8_STAGE_B(PG8_SB(1, 0), rB, cB + kstep, vB); PG8_STAGE(PG8_SA(1, 0), rA, cA + kstep, vA0); PG8_STAGE_B(PG8_SB(1, 1), rB, cB + hstepB + kstep, vB);
    PG8_WAIT_V(6); PG8_BAR;
    typename P::U nn = cur; unsigned nnA0[2], nnA1[2];
    bool has_next = prob.next(1, nxt);
    unsigned nA = has_next ? prob.a_soff(nxt) : cA, nB = has_next ? prob.b_soff(nxt) : cB;
    if constexpr (P::GATHER) { if (has_next) prob.a_offs(1, nxt, R, C, nA0, nA1); else { nA0[0] = vA0[0]; nA0[1] = vA0[1]; nA1[0] = vA1[0]; nA1[1] = vA1[1]; } }
    for (;;) {
        if constexpr (P::EPI_PF) prob.epi_pf(cur, wid, lane);
        if constexpr (P::ZC && MK_ZEROC) {
            { constexpr int t = 0;
            const bool last = (t == nt - 2);
            const unsigned a1 = cA + (unsigned)((t + 1) & P::KMASK) * kstep;
            const unsigned a2 = last ? nA : cA + (unsigned)((t + 2) & P::KMASK) * kstep, b2 = last ? nB : cB + (unsigned)((t + 2) & P::KMASK) * kstep;
            const unsigned a3 = last ? nA + kstep : cA + (unsigned)((t + 3) & P::KMASK) * kstep, b3 = last ? nB + kstep : cB + (unsigned)((t + 3) & P::KMASK) * kstep;
            unsigned wA0[2], wA1[2];
            if constexpr (P::GATHER) { wA0[0] = last ? nA0[0] : vA0[0]; wA0[1] = last ? nA0[1] : vA0[1]; wA1[0] = last ? nA1[0] : vA1[0]; wA1[1] = last ? nA1[1] : vA1[1]; }
            else { wA0[0] = vA0[0]; wA0[1] = vA0[1]; wA1[0] = vA0[0]; wA1[1] = vA0[1]; }
            PG8_LDB(B0, 0, 0); PG8_LDB(B1, 0, 1); PG8_SCHED; PG8_LDA(At, 0, 0); PG8_STAGE(PG8_SA(1, 1), rA, a1 + hstepA, vA1);
            PG8_WAIT_V(8); PG8_WAIT_L(0); PG8_BAR; PG8_MMA0(0, 0, At, B0); PG8_MMA0(0, 1, At, B1); PG8_BAR; PG8_SCHED;
            PG8_LDA(At, 0, 1); PG8_STAGE_B(PG8_SB(0, 0), rB, b2, vB); PG8_STAGE_B(PG8_SB(0, 1), rB, b2 + hstepB, vB); PG8_STAGE(PG8_SA(0, 0), rA, a2, wA0);
            PG8_WAIT_V(8); PG8_WAIT_L(0); PG8_BAR; PG8_MMA0(1, 0, At, B0); PG8_MMA0(1, 1, At, B1); PG8_BAR; PG8_SCHED;
            PG8_LDB(B0, 1, 0); PG8_LDB(B1, 1, 1); PG8_SCHED; PG8_LDA(At, 1, 0); PG8_STAGE(PG8_SA(0, 1), rA, a2 + hstepA, wA1);
            PG8_WAIT_V(8); PG8_WAIT_L(0); PG8_BAR; PG8_MMA(0, 0, At, B0); PG8_MMA(0, 1, At, B1); PG8_BAR; PG8_SCHED;
            PG8_LDA(At, 1, 1); PG8_STAGE_B(PG8_SB(1, 0), rB, b3, vB); PG8_STAGE_B(PG8_SB(1, 1), rB, b3 + hstepB, vB); PG8_STAGE(PG8_SA(1, 0), rA, a3, wA0);
            PG8_WAIT_V(8); PG8_WAIT_L(0); PG8_BAR; PG8_MMA(1, 0, At, B0); PG8_MMA(1, 1, At, B1); PG8_BAR; PG8_SCHED;
            }
            for (int t = 2; t < nt; t += 2) {
            const bool last = (t == nt - 2);
            const unsigned a1 = cA + (unsigned)((t + 1) & P::KMASK) * kstep;
            const unsigned a2 = last ? nA : cA + (unsigned)((t + 2) & P::KMASK) * kstep, b2 = last ? nB : cB + (unsigned)((t + 2) & P::KMASK) * kstep;
            const unsigned a3 = last ? nA + kstep : cA + (unsigned)((t + 3) & P::KMASK) * kstep, b3 = last ? nB + kstep : cB + (unsigned)((t + 3) & P::KMASK) * kstep;
            unsigned wA0[2], wA1[2];
            if constexpr (P::GATHER) { wA0[0] = last ? nA0[0] : vA0[0]; wA0[1] = last ? nA0[1] : vA0[1]; wA1[0] = last ? nA1[0] : vA1[0]; wA1[1] = last ? nA1[1] : vA1[1]; }
            else { wA0[0] = vA0[0]; wA0[1] = vA0[1]; wA1[0] = vA0[0]; wA1[1] = vA0[1]; }
            PG8_LDB(B0, 0, 0); PG8_LDB(B1, 0, 1); PG8_SCHED; PG8_LDA(At, 0, 0); PG8_STAGE(PG8_SA(1, 1), rA, a1 + hstepA, vA1);
            PG8_WAIT_V(8); PG8_WAIT_L(0); PG8_BAR; PG8_MMA(0, 0, At, B0); PG8_MMA(0, 1, At, B1); PG8_BAR; PG8_SCHED;
            PG8_LDA(At, 0, 1); PG8_STAGE_B(PG8_SB(0, 0), rB, b2, vB); PG8_STAGE_B(PG8_SB(0, 1), rB, b2 + hstepB, vB); PG8_STAGE(PG8_SA(0, 0), rA, a2, wA0);
            PG8_WAIT_V(8); PG8_WAIT_L(0); PG8_BAR; PG8_MMA(1, 0, At, B0); PG8_MMA(1, 1, At, B1); PG8_BAR; PG8_SCHED;
            PG8_LDB(B0, 1, 0); PG8_LDB(B1, 1, 1); PG8_SCHED; PG8_LDA(At, 1, 0); PG8_STAGE(PG8_SA(0, 1), rA, a2 + hstepA, wA1);
            PG8_WAIT_V(8); PG8_WAIT_L(0); PG8_BAR; PG8_MMA(0, 0, At, B0); PG8_MMA(0, 1, At, B1); PG8_BAR; PG8_SCHED;
            PG8_LDA(At, 1, 1); PG8_STAGE_B(PG8_SB(1, 0), rB, b3, vB); PG8_STAGE_B(PG8_SB(1, 1), rB, b3 + hstepB, vB); PG8_STAGE(PG8_SA(1, 0), rA, a3, wA0);
            PG8_WAIT_V(8); PG8_WAIT_L(0); PG8_BAR; PG8_MMA(1, 0, At, B0); PG8_MMA(1, 1, At, B1); PG8_BAR; PG8_SCHED;
            }
        } else {
        for (int t = 0; t < nt; t += 2) {
            const bool last = (t == nt - 2);
            const unsigned a1 = cA + (unsigned)((t + 1) & P::KMASK) * kstep;
            const unsigned a2 = last ? nA : cA + (unsigned)((t + 2) & P::KMASK) * kstep, b2 = last ? nB : cB + (unsigned)((t + 2) & P::KMASK) * kstep;
            const unsigned a3 = last ? nA + kstep : cA + (unsigned)((t + 3) & P::KMASK) * kstep, b3 = last ? nB + kstep : cB + (unsigned)((t + 3) & P::KMASK) * kstep;
            unsigned wA0[2], wA1[2];
            if constexpr (P::GATHER) { wA0[0] = last ? nA0[0] : vA0[0]; wA0[1] = last ? nA0[1] : vA0[1]; wA1[0] = last ? nA1[0] : vA1[0]; wA1[1] = last ? nA1[1] : vA1[1]; }
            else { wA0[0] = vA0[0]; wA0[1] = vA0[1]; wA1[0] = vA0[0]; wA1[1] = vA0[1]; }
            PG8_LDB(B0, 0, 0); PG8_LDB(B1, 0, 1); PG8_SCHED; PG8_LDA(At, 0, 0); PG8_STAGE(PG8_SA(1, 1), rA, a1 + hstepA, vA1);
            PG8_WAIT_V(8); PG8_WAIT_L(0); PG8_BAR; PG8_MMA(0, 0, At, B0); PG8_MMA(0, 1, At, B1); PG8_BAR; PG8_SCHED;
            PG8_LDA(At, 0, 1); PG8_STAGE_B(PG8_SB(0, 0), rB, b2, vB); PG8_STAGE_B(PG8_SB(0, 1), rB, b2 + hstepB, vB); PG8_STAGE(PG8_SA(0, 0), rA, a2, wA0);
            PG8_WAIT_V(8); PG8_WAIT_L(0); PG8_BAR; PG8_MMA(1, 0, At, B0); PG8_MMA(1, 1, At, B1); PG8_BAR; PG8_SCHED;
            PG8_LDB(B0, 1, 0); PG8_LDB(B1, 1, 1); PG8_SCHED; PG8_LDA(At, 1, 0); PG8_STAGE(PG8_SA(0, 1), rA, a2 + hstepA, wA1);
            PG8_WAIT_V(8); PG8_WAIT_L(0); PG8_BAR; PG8_MMA(0, 0, At, B0); PG8_MMA(0, 1, At, B1); PG8_BAR; PG8_SCHED;
            PG8_LDA(At, 1, 1); PG8_STAGE_B(PG8_SB(1, 0), rB, b3, vB); PG8_STAGE_B(PG8_SB(1, 1), rB, b3 + hstepB, vB); PG8_STAGE(PG8_SA(1, 0), rA, a3, wA0);
            PG8_WAIT_V(8); PG8_WAIT_L(0); PG8_BAR; PG8_MMA(1, 0, At, B0); PG8_MMA(1, 1, At, B1); PG8_BAR; PG8_SCHED;
        }
        }
        const bool has_nn = has_next && prob.next(ui + 2, nn);
        const unsigned nnA = has_nn ? prob.a_soff(nn) : nA, nnB = has_nn ? prob.b_soff(nn) : nB;
        if constexpr (P::GATHER) { if (has_nn) prob.a_offs(ui + 2, nn, R, C, nnA0, nnA1); else { nnA0[0] = nA0[0]; nnA0[1] = nA0[1]; nnA1[0] = nA1[0]; nnA1[1] = nA1[1]; } }
        if constexpr (P::FP8) asm volatile("s_nop 15\n\ts_nop 7" ::: "memory");
        if constexpr (P::ALIGN) { if (wr == 0) PG8_BAR; }
        { int fr_ = fr, fq_ = fq; asm volatile("" : "+v"(fr_), "+v"(fq_));
          prob.epi(acc, cur, wr, wc, fr_, fq_); if constexpr (P::EPIREP > 1) { asm volatile("" : "+v"(fr_), "+v"(fq_) :: "memory"); prob.epi(acc, cur, wr, wc, fr_, fq_); } }
        if (!has_next) break;
        if (!(P::ZC && MK_ZEROC) && !prob.keep_acc(cur)) {
#pragma unroll
        for (int a = 0; a < 2; ++a)
#pragma unroll
            for (int b = 0; b < 2; ++b)
#pragma unroll
                for (int m = 0; m < 4; ++m)
#pragma unroll
                    for (int n = 0; n < 2; ++n) acc[a][b][m][n] = (f32x4){0.f, 0.f, 0.f, 0.f};
        }
        cur = nxt; cA = nA; cB = nB; if constexpr (P::GATHER) { vA0[0] = nA0[0]; vA0[1] = nA0[1]; vA1[0] = nA1[0]; vA1[1] = nA1[1]; } nt = prob.nt(cur); ++ui;
        nxt = nn; has_next = has_nn; nA = nnA; nB = nnB; if constexpr (P::GATHER) { nA0[0] = nnA0[0]; nA0[1] = nnA0[1]; nA1[0] = nnA1[0]; nA1[1] = nnA1[1]; }
        if constexpr (P::ALIGN) { if (wr == 1) PG8_BAR; }
    }
    PG8_WAIT_V(0);
    if constexpr (!P::ALIGN) { if (wr == 0) PG8_BAR; }
    PG8_BAR;
#undef PG8_SA
#undef PG8_SB
#undef PG8_STAGE
#undef PG8_STAGE_B
#undef PG8_LDA
#undef PG8_LDB
#undef PG8_MMA
#undef PG8_MMA0
#undef PG8_CAT
#undef PG8_WAIT_V
#undef PG8_WAIT_L
#undef PG8_BAR
#undef PG8_SCHED
}
}

struct Args { const float* in[20]; float* out; unsigned char* ws; int ph_lo, ph_hi; };
struct Frame {
    LAS unsigned char* lds;
    unsigned* ctl;
    unsigned char* ws;
    const Args* a;
    int tid, lane, wave, G, bx;
};
#define F_x          (F.a->in[0])
#define F_meta       (F.a->in[1])
#define F_ln_in_g    (F.a->in[2])
#define F_ln_in_b    (F.a->in[3])
#define F_w_in       (F.a->in[4])
#define F_conv_w     (F.a->in[5])
#define F_w_a_out    (F.a->in[6])
#define F_pool_w     (F.a->in[7])
#define F_pool_scale (F.a->in[8])
#define F_w_o        (F.a->in[9])
#define F_ln1_g      (F.a->in[10])
#define F_ln1_b      (F.a->in[11])
#define F_router_w   (F.a->in[12])
#define F_router_b   (F.a->in[13])
#define F_w_gate_up  (F.a->in[14])
#define F_b_gate_up  (F.a->in[15])
#define F_w_down     (F.a->in[16])
#define F_b_down     (F.a->in[17])
#define F_ln2_g      (F.a->in[18])
#define F_ln2_b      (F.a->in[19])
#define F_out        (F.a->out)
#define WSB(off)     ((bf16_t*)(F.ws + (off)))
#define F_Win_t  WSB(WS_WIN_T)
#define F_Wa_t   WSB(WS_WA_T)
#define F_Wo_t   WSB(WS_WO_T)
#define F_Wp_t   WSB(WS_WP_T)
#define F_RWhi   WSB(WS_RW)
#define F_RWlo   WSB(WS_RW + 128 * 1024)
#define F_H0meta WSB(WS_META)
#define F_CUmeta WSB(WS_META + 64 * 1024)
#define F_Vmeta  WSB(WS_META + 128 * 1024)
#define F_H0metaQ ((unsigned char*)(F.ws + WS_META + 160 * 1024))
#define F_Wgu8   ((unsigned char*)(F.ws + WS_WGU_T))
#define F_Wd8    ((unsigned char*)(F.ws + WS_WD_T))
#define F_H1Q    ((unsigned char*)(F.ws + WS_H1Q))
#define F_H0Q    ((unsigned char*)(F.ws + WS_H0Q))
#define F_Win8   ((unsigned char*)(F.ws + WS_WIN8))
#define F_ACT8   ((unsigned char*)(F.ws + WS_ACT))
#define F_H0     WSB(WS_H0)
#define F_BG8    ((unsigned char*)(F.ws + WS_BG))
#define F_CU     WSB(WS_CU)
#define F_V      WSB(WS_V)
#define F_G8     ((unsigned char*)(F.ws + WS_G))
#define F_AP8    ((unsigned char*)(F.ws + WS_AP))
#define F_Wa8    ((unsigned char*)(F.ws + WS_WA_T))
#define F_Wp8    ((unsigned char*)(F.ws + WS_WP_T))
#define F_YB     WSB(WS_YB)
#define F_MERGED8 ((unsigned char*)(F.ws + WS_MERGED))
#define F_Wo8    ((unsigned char*)(F.ws + WS_WO_T))
#define F_H1     WSB(WS_H1)
#define F_OSLOT8 ((unsigned char*)(F.ws + WS_OSLOT))
#define F_MIX    WSB(WS_Z)
#define F_topk_slot ((int*)(F.ws + WS_ROUTE))
#define F_tok_list  ((int*)(F.ws + WS_ROUTE + 1 * MiB))
#define F_wt_list   ((float*)(F.ws + WS_ROUTE + 4 * MiB))


#define QS(i) (((const LAS float*)(F.lds + L_QS))[i])
template <int LDA_>
__device__ __forceinline__ void dense_a_offs(const int (&R)[2], const int (&C)[2], unsigned (&v0)[2], unsigned (&v1)[2]) {
#pragma unroll
    for (int i = 0; i < 2; ++i) { v0[i] = (unsigned)(R[i] * LDA_ + C[i]) * 2u; v1[i] = (unsigned)((R[i] + 128) * LDA_ + C[i]) * 2u; }
}
__device__ __forceinline__ __amdgpu_buffer_rsrc_t mkrsrc(const void* p, size_t bytes) { return __builtin_amdgcn_make_buffer_rsrc((void*)p, 0, (int)(unsigned)bytes, 0x00020000); }
#define EPI_ROW(ai, m) ((ai) * 128 + wr * 64 + (m) * 16 + fr)
#define EPI_COL8(bj) ((bj) * 128 + wc * 32 + 8 * fq)

struct ProbInProj {
    static constexpr bool I8 = false; static constexpr bool B_NT = false; static constexpr bool ALIGN = true; static constexpr int KMASK = (MK_P1_KREP > 1) ? 31 : 0x7fffffff, EPIREP = MK_P1_EPIREP; static constexpr float ASC = 1.0f / MK_P1_KREP; static constexpr bool FP8 = false; static constexpr int LDB = 2048, LDA = 2048; static constexpr bool GATHER = false; static constexpr bool EPI_PF = false; static constexpr bool ZC = MK_ZC_DENSE;
    struct U { int pm, pn; };
    int G, c; const bf16_t *A, *Bt; bf16_t *BG, *CU, *V, *Gt; const float* pool_scale;
    __device__ __forceinline__ bool next(int i, U& u) const { if (!pg8::order_unit(i, G, c, T / 256, NT_BF, u.pm, u.pn)) return false; u.pn = u.pn < 8 ? u.pn : u.pn + 16; return true; }
    __device__ __forceinline__ __amdgpu_buffer_rsrc_t a_rsrc() const { return mkrsrc(A, (size_t)T * 2048 * 2); }
    __device__ __forceinline__ __amdgpu_buffer_rsrc_t b_rsrc() const { return mkrsrc(Bt, (size_t)DIN * 2048 * 2); }
    __device__ __forceinline__ unsigned a_soff(const U& u) const { return (unsigned)u.pm * (256u * 2048u * 2u); }
    __device__ __forceinline__ unsigned b_soff(const U& u) const { return (unsigned)u.pn * (256u * 2048u * 2u); }
    __device__ __forceinline__ int nt(const U&) const { return 32 * MK_P1_KREP; }
    __device__ __forceinline__ bool keep_acc(const U&) const { return false; }
    __device__ __forceinline__ void epi(f32x4 (&acc_)[2][2][4][2], const U& u, int wr, int wc, int fr, int fq) const {
        f32x4 acc[2][2][4][2];
#pragma unroll
        for (int a = 0; a < 2; ++a)
#pragma unroll
            for (int b = 0; b < 2; ++b)
#pragma unroll
                for (int m = 0; m < 4; ++m)
#pragma unroll
                    for (int n = 0; n < 2; ++n) acc[a][b][m][n] = (MK_P1_KREP > 1) ? acc_[a][b][m][n] * ASC : acc_[a][b][m][n];
        const int pn = u.pn; const size_t row0 = (size_t)u.pm * 256;
        if (pn >= 8 && pn < 24) {
            const int cb = (pn - 8) * 128 + wc * 32 + 8 * fq;
#pragma unroll
            for (int ai = 0; ai < 2; ++ai)
#pragma unroll
                for (int m = 0; m < 4; ++m) { const f32x4 p0 = acc[ai][0][m][0] * acc[ai][1][m][0], p1 = acc[ai][0][m][1] * acc[ai][1][m][1];
                    *(u32x4*)(CU + (row0 + EPI_ROW(ai, m)) * 2048 + cb) = pack8(p0, p1); }
        } else if (pn < 28) {
            bf16_t* O; int ldc, cb;
            if (pn < 8) { O = BG; ldc = 2048; cb = pn * 256; } else { O = V; ldc = 1024; cb = (pn - 24) * 256; }
#pragma unroll
            for (int ai = 0; ai < 2; ++ai)
#pragma unroll
                for (int m = 0; m < 4; ++m)
#pragma unroll
                    for (int bj = 0; bj < 2; ++bj) *(u32x4*)(O + (row0 + EPI_ROW(ai, m)) * ldc + cb + EPI_COL8(bj)) = pack8(acc[ai][bj][m][0], acc[ai][bj][m][1]);
        }
    }
};

struct ProbInProj8 {
    static constexpr bool I8 = true; static constexpr bool B_NT = false; static constexpr bool ALIGN = MK_ALIGN8; static constexpr int KMASK = 0x7fffffff, EPIREP = 1; static constexpr bool FP8 = false; static constexpr int LDB = 1024, LDA = 1024; static constexpr bool GATHER = false; static constexpr bool EPI_PF = false; static constexpr bool ZC = MK_ZC_DENSE;
    struct U { int pm, pn; };
    int G, c; const unsigned char *A8, *B8; bf16_t *CU, *V; unsigned char *BG8, *G8; float deq, bgq;
    __device__ __forceinline__ bool next(int i, U& u) const { if (!pg8::order_unit(i, G, c, T / 256, 44 - NT_BF, u.pm, u.pn)) return false; if (!MK_ALL_FP8) u.pn = u.pn < 16 ? u.pn + 8 : u.pn + 12; return true; }
    __device__ __forceinline__ __amdgpu_buffer_rsrc_t a_rsrc() const { return mkrsrc(A8, (size_t)T * 2048); }
    __device__ __forceinline__ __amdgpu_buffer_rsrc_t b_rsrc() const { return mkrsrc(B8, (size_t)DIN * 2048); }
    __device__ __forceinline__ unsigned a_soff(const U& u) const { return (unsigned)u.pm * (256u * 2048u); }
    __device__ __forceinline__ unsigned b_soff(const U& u) const { return (unsigned)u.pn * (256u * 2048u); }
    __device__ __forceinline__ int nt(const U&) const { return 16; }
    __device__ __forceinline__ bool keep_acc(const U&) const { return false; }
    __device__ __forceinline__ void epi(f32x4 (&acc)[2][2][4][2], const U& u, int wr, int wc, int fr, int fq) const {
        const int pn = u.pn; const size_t row0 = (size_t)u.pm * 256;
        const float DEQ = deq;
        if (pn >= 8 && pn < 24) {
            const int cb = (pn - 8) * 128 + wc * 32 + 8 * fq;
#pragma unroll
            for (int ai = 0; ai < 2; ++ai)
#pragma unroll
                for (int m = 0; m < 4; ++m) { const f32x4 p0 = i2f(acc[ai][0][m][0]) * i2f(acc[ai][1][m][0]) * (DEQ * DEQ), p1 = i2f(acc[ai][0][m][1]) * i2f(acc[ai][1][m][1]) * (DEQ * DEQ);
                    *(u32x4*)(CU + (row0 + EPI_ROW(ai, m)) * 2048 + cb) = pack8(p0, p1); }
        } else if (pn < 28) {
            if (pn < 8) {
                const int cb = pn * 256; const float qf = DEQ * bgq;
#pragma unroll
                for (int ai = 0; ai < 2; ++ai)
#pragma unroll
                    for (int m = 0; m < 4; ++m)
#pragma unroll
                        for (int bj = 0; bj < 2; ++bj) { const f32x4 v0 = i2f(acc[ai][bj][m][0]) * qf, v1 = i2f(acc[ai][bj][m][1]) * qf; u32x2 w; w.x = pack4_i8(v0[0], v0[1], v0[2], v0[3]); w.y = pack4_i8(v1[0], v1[1], v1[2], v1[3]);
                            *(u32x2*)(BG8 + (row0 + EPI_ROW(ai, m)) * 2048 + cb + EPI_COL8(bj)) = w; }
            } else {
                const int cb = (pn - 24) * 256;
#pragma unroll
                for (int ai = 0; ai < 2; ++ai)
#pragma unroll
                    for (int m = 0; m < 4; ++m)
#pragma unroll
                        for (int bj = 0; bj < 2; ++bj) *(u32x4*)(V + (row0 + EPI_ROW(ai, m)) * 1024 + cb + EPI_COL8(bj)) = pack8(i2f(acc[ai][bj][m][0]) * DEQ, i2f(acc[ai][bj][m][1]) * DEQ);
            }
        } else {
            const int cb = (pn - 28) * 256;
#pragma unroll
            for (int ai = 0; ai < 2; ++ai)
#pragma unroll
                for (int m = 0; m < 4; ++m)
#pragma unroll
                    for (int bj = 0; bj < 2; ++bj) { f32x4 s0, s1;
#pragma unroll
                        for (int j = 0; j < 4; j += 2) {
                            const f32x4 c0 = i2f(acc[ai][bj][m][0]), c1 = i2f(acc[ai][bj][m][1]);
                            const f32x2 e0 = (f32x2){c0[j], c0[j + 1]} * (-DEQ * 1.4426950408889634f), e1 = (f32x2){c1[j], c1[j + 1]} * (-DEQ * 1.4426950408889634f);
                            f32x2 d0, d1; d0.x = __builtin_amdgcn_exp2f(e0.x); d0.y = __builtin_amdgcn_exp2f(e0.y); d1.x = __builtin_amdgcn_exp2f(e1.x); d1.y = __builtin_amdgcn_exp2f(e1.y); d0 = d0 + 1.0f; d1 = d1 + 1.0f;
                            f32x2 r0, r1; r0.x = __builtin_amdgcn_rcpf(d0.x); r0.y = __builtin_amdgcn_rcpf(d0.y); r1.x = __builtin_amdgcn_rcpf(d1.x); r1.y = __builtin_amdgcn_rcpf(d1.y);
                            r0 = r0 * 255.0f; r1 = r1 * 255.0f;
                            s0[j] = r0.x; s0[j + 1] = r0.y; s1[j] = r1.x; s1[j + 1] = r1.y; }
                        u32x2 w; w.x = pack4_u8(s0[0], s0[1], s0[2], s0[3]); w.y = pack4_u8(s1[0], s1[1], s1[2], s1[3]);
                        *(u32x2*)(G8 + (row0 + EPI_ROW(ai, m)) * 4096 + cb + EPI_COL8(bj)) = w; }
        }
    }
};

struct ProbMix {
    static constexpr bool I8 = false; static constexpr bool B_NT = false; static constexpr bool ALIGN = true; static constexpr int KMASK = 0x7fffffff, EPIREP = 1; static constexpr bool FP8 = true; static constexpr int LDB = 1024, LDA = APITCH / 2; static constexpr bool GATHER = false; static constexpr bool EPI_PF = false; static constexpr bool ZC = false;
    struct U { int pm, pn, type; };
    int G, c; const unsigned char *AP, *Wp_t, *Wa_t; const unsigned char* G8; const float* pool_scale; bf16_t* YB; unsigned char* MERGED;
    __device__ __forceinline__ bool next(int i, U& u) const { u.type = i & 1; return pg8::order_unit(i >> 1, G, c, T / 256, D / 256, u.pm, u.pn); }
    __device__ __forceinline__ __amdgpu_buffer_rsrc_t a_rsrc() const { return mkrsrc(AP, (size_t)T * APITCH); }
    __device__ __forceinline__ __amdgpu_buffer_rsrc_t b_rsrc() const { return mkrsrc(Wa_t, (size_t)(WS_WP_T - WS_WA_T) + (size_t)2048 * 2048); }
    __device__ __forceinline__ unsigned a_soff(const U& u) const { return (unsigned)u.pm * (256u * APITCH) + (u.type == 0 ? 2048u + (unsigned)(u.pn >> 1) * 256u : 0u); }
    __device__ __forceinline__ unsigned b_soff(const U& u) const { return (u.type == 0 ? (unsigned)(WS_WP_T - WS_WA_T) : 0u) + (unsigned)u.pn * (256u * 2048u); }
    __device__ __forceinline__ int nt(const U& u) const { return u.type == 0 ? 2 : 16; }
    __device__ __forceinline__ bool keep_acc(const U& u) const { return u.type == 0; }
    __device__ __forceinline__ void epi(f32x4 (&acc)[2][2][4][2], const U& u, int wr, int wc, int fr, int fq) const {
        const size_t row0 = (size_t)u.pm * 256; const int cb = u.pn * 256;
        if (u.type == 0) {
            f32x4 ps[2][2];
#pragma unroll
            for (int bj = 0; bj < 2; ++bj)
#pragma unroll
                for (int n = 0; n < 2; ++n) ps[bj][n] = *(const f32x4*)(pool_scale + cb + EPI_COL8(bj) + 4 * n) * (P3_WA_SCALE / P3_WP_SCALE);
            u32x2 gaw[2][4][2], gbw[2][4][2];
#pragma unroll
            for (int ai = 0; ai < 2; ++ai)
#pragma unroll
                for (int m = 0; m < 4; ++m) { const size_t r = row0 + EPI_ROW(ai, m);
#pragma unroll
                    for (int bj = 0; bj < 2; ++bj) { gaw[ai][m][bj] = *(const u32x2*)(G8 + r * 4096 + cb + EPI_COL8(bj)); gbw[ai][m][bj] = *(const u32x2*)(G8 + r * 4096 + 2048 + cb + EPI_COL8(bj)); } }
#pragma unroll
            for (int ai = 0; ai < 2; ++ai)
#pragma unroll
                for (int m = 0; m < 4; ++m)
#pragma unroll
                    for (int bj = 0; bj < 2; ++bj) { const f32x4 g0 = u8x4_to_f(gaw[ai][m][bj].x), g1 = u8x4_to_f(gaw[ai][m][bj].y), h0 = u8x4_to_f(gbw[ai][m][bj].x) * ps[bj][0], h1 = u8x4_to_f(gbw[ai][m][bj].y) * ps[bj][1];
#pragma unroll
                        for (int j = 0; j < 4; ++j) { acc[ai][bj][m][0][j] *= h0[j] * __builtin_amdgcn_rcpf(g0[j]); acc[ai][bj][m][1][j] *= h1[j] * __builtin_amdgcn_rcpf(g1[j]); } }
        } else {
            u32x2 gaw[2][4][2];
#pragma unroll
            for (int ai = 0; ai < 2; ++ai)
#pragma unroll
                for (int m = 0; m < 4; ++m)
#pragma unroll
                    for (int bj = 0; bj < 2; ++bj) gaw[ai][m][bj] = *(const u32x2*)(G8 + (row0 + EPI_ROW(ai, m)) * 4096 + cb + EPI_COL8(bj));
#pragma unroll
            for (int ai = 0; ai < 2; ++ai)
#pragma unroll
                for (int m = 0; m < 4; ++m)
#pragma unroll
                    for (int bj = 0; bj < 2; ++bj) { const f32x4 g0 = u8x4_to_f(gaw[ai][m][bj].x) * (P4_M_SCALE / (255.0f * P3_A_SCALE * P3_WA_SCALE)), g1 = u8x4_to_f(gaw[ai][m][bj].y) * (P4_M_SCALE / (255.0f * P3_A_SCALE * P3_WA_SCALE));
                        const f32x4 o0 = acc[ai][bj][m][0] * g0, o1 = acc[ai][bj][m][1] * g1; u32x2 w8; w8.x = pack4_fp8(clamp448(o0[0]), clamp448(o0[1]), clamp448(o0[2]), clamp448(o0[3])); w8.y = pack4_fp8(clamp448(o1[0]), clamp448(o1[1]), clamp448(o1[2]), clamp448(o1[3]));
                        *(u32x2*)(MERGED + (row0 + EPI_ROW(ai, m)) * 2048 + cb + EPI_COL8(bj)) = w8; }
        }
    }
};

struct ProbWo {
    static constexpr bool I8 = false; static constexpr bool B_NT = false; static constexpr bool ALIGN = true; static constexpr int KMASK = (MK_P4_KREP > 1) ? 15 : 0x7fffffff, EPIREP = 1; static constexpr bool FP8 = true; static constexpr int LDB = 1024, LDA = 1024; static constexpr bool GATHER = false; static constexpr bool EPI_PF = false; static constexpr bool ZC = MK_ZC_DENSE;
    struct U { int pm, pn; };
    int G, c; const unsigned char *A, *Bt; bf16_t* MIX;
    __device__ __forceinline__ bool next(int i, U& u) const { return pg8::order_unit(i, G, c, T / 256, D / 256, u.pm, u.pn); }
    __device__ __forceinline__ __amdgpu_buffer_rsrc_t a_rsrc() const { return mkrsrc(A, (size_t)T * 2048); }
    __device__ __forceinline__ __amdgpu_buffer_rsrc_t b_rsrc() const { return mkrsrc(Bt, (size_t)2048 * 2048); }
    __device__ __forceinline__ unsigned a_soff(const U& u) const { return (unsigned)u.pm * (256u * 2048u); }
    __device__ __forceinline__ unsigned b_soff(const U& u) const { return (unsigned)u.pn * (256u * 2048u); }
    __device__ __forceinline__ int nt(const U&) const { return 16 * MK_P4_KREP; }
    __device__ __forceinline__ bool keep_acc(const U&) const { return false; }
    __device__ __forceinline__ void epi(f32x4 (&acc)[2][2][4][2], const U& u, int wr, int wc, int fr, int fq) const {
        const size_t row0 = (size_t)u.pm * 256; const int cb = u.pn * 256;
#pragma unroll
        for (int ai = 0; ai < 2; ++ai)
#pragma unroll
            for (int m = 0; m < 4; ++m)
#pragma unroll
                for (int bj = 0; bj < 2; ++bj) *(u32x4*)(MIX + (row0 + EPI_ROW(ai, m)) * 2048 + cb + EPI_COL8(bj)) = pack8(acc[ai][bj][m][0] * (1.0f / (MK_P4_KREP * P4_M_SCALE * P4_WO_SCALE)), acc[ai][bj][m][1] * (1.0f / (MK_P4_KREP * P4_M_SCALE * P4_WO_SCALE)));
    }
};

__device__ __forceinline__ int moe_build_tables(Frame& F) {
    LAS int* cntl = (LAS int*)(F.lds + L_CNT); LAS int* tbase = (LAS int*)(F.lds + L_TBASE); LAS int* tile_e = (LAS int*)(F.lds + L_TILE_E);
    if (F.tid < 64) {
        const int e = F.tid & 31; const int cnt = (int)__hip_atomic_load(F.ctl + CW_CNT + e, RLX_AGENT); const int ntile = (cnt + 255) >> 8;
        int incl = ntile;
#pragma unroll
        for (int o = 1; o < 32; o <<= 1) { const int v = __shfl_up(incl, o, 32); if (e >= o) incl += v; }
        if (F.tid < 32) { cntl[e] = cnt; tbase[e] = incl - ntile; if (e == 31) tbase[32] = incl; }
    }
    __syncthreads();
    const int NT = __builtin_amdgcn_readfirstlane(tbase[32]);
    for (int rt = F.tid; rt < NT; rt += NTHREADS) { int e = 0;
#pragma unroll 1
        for (int k = 1; k < 32; ++k) if (tbase[k] <= rt) e = k;
        tile_e[rt] = e; }
    __syncthreads();
    return NT;
}

__device__ __forceinline__ bool moe_unit(int i, int G, int c, int NT, int NN, const LAS int* tbase, int& rt, int& j, int& e) {
    const int nwg = NT * NN; const long L = (long)i * G + c; if (L >= nwg) return false;
    int wgid = (int)L; { const int q = nwg / 8, xcd = wgid % 8, off = wgid / 8; wgid = xcd * q + off; }
    const int lane = threadIdx.x & 63;
    const int tb = tbase[lane < 32 ? lane : 32];
    e = __builtin_popcountll(__ballot(tb * NN <= wgid)) - 1;
    const int t0 = __builtin_amdgcn_readfirstlane(tbase[e]), t1 = __builtin_amdgcn_readfirstlane(tbase[e + 1]);
    const int local = wgid - t0 * NN, gsz = t1 - t0;
    j = local / gsz; rt = t0 + (local - j * gsz); return true;
}

struct ProbGateUp {
    static constexpr bool I8 = true; static constexpr bool B_NT = MK_B_NT; static constexpr bool ALIGN = MK_ALIGN8; static constexpr int KMASK = (MK_P6_KREP > 1) ? 15 : 0x7fffffff, EPIREP = MK_P6_EPIREP; static constexpr bool FP8 = false; static constexpr int LDB = 1024, LDA = 1024; static constexpr bool GATHER = true; static constexpr bool EPI_PF = MK_EPI_PF; static constexpr bool ZC = MK_ZC_MOE;
    struct U { int rt, j, e, ui; };
    int G, c, NT; LAS unsigned char* lds; const unsigned char *H1Q, *Wgu8; const float* b_gate_up; unsigned char* ACT8;
    __device__ __forceinline__ bool next(int i, U& u) const { u.ui = i; return moe_unit(i, G, c, NT, 16, (const LAS int*)(lds + L_TBASE), u.rt, u.j, u.e); }
    __device__ __forceinline__ __amdgpu_buffer_rsrc_t a_rsrc() const { return mkrsrc(H1Q, (size_t)T * 2048); }
    __device__ __forceinline__ __amdgpu_buffer_rsrc_t b_rsrc() const { return mkrsrc(Wgu8, (size_t)NE * 4096 * 2048); }
    __device__ __forceinline__ unsigned a_soff(const U&) const { return 0u; }
    __device__ __forceinline__ unsigned b_soff(const U& u) const { return ((unsigned)u.e * 4096u + (unsigned)u.j * 256u) * 2048u; }
    __device__ __forceinline__ int nt(const U&) const { return 16 * MK_P6_KREP; }
    __device__ __forceinline__ void a_offs(int ui, const U&, const int (&R)[2], const int (&C)[2], unsigned (&v0)[2], unsigned (&v1)[2]) const {
        const LAS int* rows = (const LAS int*)(lds + L_ROWS) + ui * 256;
#pragma unroll
        for (int i = 0; i < 2; ++i) { v0[i] = (unsigned)rows[R[i]] * 2048u + (unsigned)C[i] * 2u; v1[i] = (unsigned)rows[128 + R[i]] * 2048u + (unsigned)C[i] * 2u; }
    }
    __device__ __forceinline__ bool keep_acc(const U&) const { return false; }
    __device__ __forceinline__ void epi_pf(const U& u, int wid, int lane) const {
        if (wid == 0) __builtin_amdgcn_raw_ptr_buffer_load_lds(mkrsrc(b_gate_up, (size_t)NE * 4096 * 4), (LAS void*)(lds + L_EPI + (u.ui & 1) * 2048), 16, ((lane >> 5) * 2048 + (lane & 31) * 4) * 4, (u.e * 4096 + u.j * 128) * 4, 0, 0);
    }
    __device__ __forceinline__ void epi(f32x4 (&acc)[2][2][4][2], const U& u, int wr, int wc, int fr, int fq) const {
        const size_t row0 = (size_t)u.rt * 256; const int cb = u.j * 128 + wc * 32 + 8 * fq;
        const float* bp = b_gate_up + (size_t)u.e * 4096 + cb;
        const float DEQ = 1.0f / (((const LAS float*)(lds + L_QS))[1] * ((const LAS float*)(lds + L_QS))[3 + u.e] * MK_P6_KREP);
        constexpr float KSW = -SW_ALPHA * 1.4426950408889634f; const float DEQK = DEQ * KSW;
        f32x4 bg[2], bl1[2];
#pragma unroll
        for (int n = 0; n < 2; ++n) {
            if constexpr (EPI_PF) { const LAS float* eb = (const LAS float*)(lds + L_EPI + (u.ui & 1) * 2048) + wc * 32 + 8 * fq; bg[n] = *(const LAS f32x4*)(eb + 4 * n) * KSW; bl1[n] = *(const LAS f32x4*)(eb + 128 + 4 * n) + 1.0f; }
            else { bg[n] = *(const f32x4*)(bp + 4 * n) * KSW; bl1[n] = *(const f32x4*)(bp + 2048 + 4 * n) + 1.0f; } }
#pragma unroll
        for (int ai = 0; ai < 2; ++ai)
#pragma unroll
            for (int mp = 0; mp < 2; ++mp) { u32x2 w[2];
#pragma unroll
                for (int mm = 0; mm < 2; ++mm) { const int m = 2 * mp + mm; f32x4 o[2];
#pragma unroll
                    for (int n = 0; n < 2; ++n)
#pragma unroll
                        for (int j = 0; j < 4; j += 2) {
                            const f32x4 cg = i2f(acc[ai][0][m][n]), cl = i2f(acc[ai][1][m][n]);
                            f32x2 gk = (f32x2){cg[j], cg[j + 1]} * DEQK + (f32x2){bg[n][j], bg[n][j + 1]};
                            f32x2 l = (f32x2){cl[j], cl[j + 1]} * DEQ + (f32x2){bl1[n][j], bl1[n][j + 1]};
                            gk.x = fmaxf(gk.x, KSW * SW_LIMIT); gk.y = fmaxf(gk.y, KSW * SW_LIMIT);
                            l.x = __builtin_amdgcn_fmed3f(l.x, 1.0f - SW_LIMIT, 1.0f + SW_LIMIT); l.y = __builtin_amdgcn_fmed3f(l.y, 1.0f - SW_LIMIT, 1.0f + SW_LIMIT);
                            f32x2 d; d.x = __builtin_amdgcn_exp2f(gk.x); d.y = __builtin_amdgcn_exp2f(gk.y); d = d + 1.0f;
                            f32x2 r; r.x = __builtin_amdgcn_rcpf(d.x); r.y = __builtin_amdgcn_rcpf(d.y);
                            const f32x2 out = (l * (gk * (ACT_SCALE / KSW))) * r; o[n][j] = out.x; o[n][j + 1] = out.y; }
                    w[mm].x = pack4_fp8(o[0][0], o[0][1], o[0][2], o[0][3]); w[mm].y = pack4_fp8(o[1][0], o[1][1], o[1][2], o[1][3]); }
                const auto sx = __builtin_amdgcn_permlane16_swap(w[0].x, w[1].x, false, false); const auto sy = __builtin_amdgcn_permlane16_swap(w[0].y, w[1].y, false, false);
                u32x4 q; q.x = sx[0]; q.y = sy[0]; q.z = sx[1]; q.w = sy[1];
                const int odd = fq & 1; const int m = 2 * mp + odd;
                *(u32x4*)(ACT8 + (row0 + EPI_ROW(ai, m)) * 2048 + u.j * 128 + wc * 32 + 8 * (fq - odd)) = q; }
    }
};

struct ProbDown {
    static constexpr bool I8 = false; static constexpr bool B_NT = MK_B_NT; static constexpr bool ALIGN = MK_ALIGN8; static constexpr int KMASK = 0x7fffffff, EPIREP = MK_P7_EPIREP; static constexpr bool FP8 = true; static constexpr int LDB = 1024, LDA = 1024; static constexpr bool GATHER = false; static constexpr bool EPI_PF = MK_EPI_PF; static constexpr bool ZC = MK_ZC_MOE;
    struct U { int rt, j, e, ui; };
    int G, c, NT; LAS unsigned char* lds; const unsigned char *ACT8, *Wd8; const float *b_down, *wt_list; unsigned char* OSLOT8;
    __device__ __forceinline__ bool next(int i, U& u) const { u.ui = i; return moe_unit(i, G, c, NT, 8, (const LAS int*)(lds + L_TBASE), u.rt, u.j, u.e); }
    __device__ __forceinline__ __amdgpu_buffer_rsrc_t a_rsrc() const { return mkrsrc(ACT8, (size_t)MAXTILES * 256 * 2048); }
    __device__ __forceinline__ __amdgpu_buffer_rsrc_t b_rsrc() const { return mkrsrc(Wd8, (size_t)NE * 2048 * 2048); }
    __device__ __forceinline__ unsigned a_soff(const U& u) const { return (unsigned)u.rt * (256u * 2048u); }
    __device__ __forceinline__ unsigned b_soff(const U& u) const { return ((unsigned)u.e * 2048u + (unsigned)u.j * 256u) * 2048u; }
    __device__ __forceinline__ int nt(const U&) const { return 16; }
    __device__ __forceinline__ bool keep_acc(const U&) const { return false; }
    __device__ __forceinline__ void epi_pf(const U& u, int wid, int lane) const {
        if (wid == 0) { const int r0 = (u.rt - __builtin_amdgcn_readfirstlane(((const LAS int*)(lds + L_TBASE))[u.e])) * 256;
            __builtin_amdgcn_raw_ptr_buffer_load_lds(mkrsrc(wt_list, (size_t)NE * T * 4), (LAS void*)(lds + L_EPI + (u.ui & 1) * 2048), 16, lane * 16, (u.e * T + r0) * 4, 0, 0); }
        if (wid == 1) __builtin_amdgcn_raw_ptr_buffer_load_lds(mkrsrc(b_down, (size_t)NE * 2048 * 4), (LAS void*)(lds + L_EPI + (u.ui & 1) * 2048 + 1024), 16, lane * 16, (u.e * 2048 + u.j * 256) * 4, 0, 0);
    }
    __device__ __forceinline__ void epi(f32x4 (&acc)[2][2][4][2], const U& u, int wr, int wc, int fr, int fq) const {
        const size_t row0 = (size_t)u.rt * 256; const int cb = u.j * 256;
        const int cnt = __builtin_amdgcn_readfirstlane(((const LAS int*)(lds + L_CNT))[u.e]), r0 = (u.rt - __builtin_amdgcn_readfirstlane(((const LAS int*)(lds + L_TBASE))[u.e])) * 256;
        constexpr float DEQ = 1.0f / (ACT_SCALE * W_SCALE_D);
        const float* bp = b_down + (size_t)u.e * 2048 + cb + wc * 32 + 8 * fq; const float* wp = wt_list + (size_t)u.e * T;
        float wt[2][4]; f32x4 bv[2][2];
#pragma unroll
        for (int ai = 0; ai < 2; ++ai)
#pragma unroll
            for (int m = 0; m < 4; ++m) { const int idx = r0 + EPI_ROW(ai, m);
                if constexpr (EPI_PF) wt[ai][m] = ((const LAS float*)(lds + L_EPI + (u.ui & 1) * 2048))[EPI_ROW(ai, m)]; else wt[ai][m] = wp[idx < cnt ? idx : 0];
                if (idx >= cnt) wt[ai][m] = 0.f; }
#pragma unroll
        for (int bj = 0; bj < 2; ++bj) {
            if constexpr (EPI_PF) { const LAS float* eb = (const LAS float*)(lds + L_EPI + (u.ui & 1) * 2048 + 1024) + bj * 128 + wc * 32 + 8 * fq; bv[bj][0] = *(const LAS f32x4*)eb; bv[bj][1] = *(const LAS f32x4*)(eb + 4); }
            else { bv[bj][0] = *(const f32x4*)(bp + bj * 128); bv[bj][1] = *(const f32x4*)(bp + bj * 128 + 4); } }
#pragma unroll
        for (int ai = 0; ai < 2; ++ai)
#pragma unroll
            for (int mp = 0; mp < 2; ++mp)
#pragma unroll
                for (int bj = 0; bj < 2; ++bj) { u32x2 w[2];
#pragma unroll
                    for (int mm = 0; mm < 2; ++mm) { const int m = 2 * mp + mm; const float ws = wt[ai][m] * OS_SCALE;
                        const f32x4 o0 = (acc[ai][bj][m][0] * DEQ + bv[bj][0]) * ws, o1 = (acc[ai][bj][m][1] * DEQ + bv[bj][1]) * ws;
                        w[mm].x = pack4_fp8(clamp448(o0[0]), clamp448(o0[1]), clamp448(o0[2]), clamp448(o0[3])); w[mm].y = pack4_fp8(clamp448(o1[0]), clamp448(o1[1]), clamp448(o1[2]), clamp448(o1[3])); }
                    const auto sx = __builtin_amdgcn_permlane16_swap(w[0].x, w[1].x, false, false); const auto sy = __builtin_amdgcn_permlane16_swap(w[0].y, w[1].y, false, false);
                    u32x4 q; q.x = sx[0]; q.y = sy[0]; q.z = sx[1]; q.w = sy[1];
                    const int odd = fq & 1; const int m = 2 * mp + odd;
                    *(u32x4*)(OSLOT8 + (row0 + EPI_ROW(ai, m)) * 2048 + cb + bj * 128 + wc * 32 + 8 * (fq - odd)) = q; }
    }
};

__device__ __forceinline__ void transpose_item(const float* W, int N, bf16_t* WT, int pitch, int k0, int n0, int drow0, int lane) {
    const int kq = lane & 7, ng = lane >> 3;
    const GAS float* src = (const GAS float*)(W + (size_t)(k0 + 8 * kq) * N + n0 + 4 * ng);
    f32x4 x[8];
#pragma unroll
    for (int i = 0; i < 8; ++i) x[i] = *(const GAS f32x4*)(src + (size_t)i * N);
    GAS bf16_t* dst = (GAS bf16_t*)(WT + (size_t)(drow0 + 4 * ng) * pitch + k0 + 8 * kq);
#pragma unroll
    for (int c = 0; c < 4; ++c) { u32x4 o; o.x = cvt_pk_bf16(x[0][c], x[1][c]); o.y = cvt_pk_bf16(x[2][c], x[3][c]); o.z = cvt_pk_bf16(x[4][c], x[5][c]); o.w = cvt_pk_bf16(x[6][c], x[7][c]);
        *(GAS u32x4*)(dst + (size_t)c * pitch) = o; }
}
template <bool I8>
__device__ __forceinline__ void transpose_item_q8(const float* W, int N, unsigned char* WT, int pitch, int k0, int n0, int drow0, float scale, int lane) {
    const int kq = lane & 7, ng = lane >> 3;
    const GAS float* src = (const GAS float*)(W + (size_t)(k0 + 16 * kq) * N + n0 + 4 * ng);
    f32x4 x[16];
#pragma unroll
    for (int i = 0; i < 16; ++i) x[i] = __builtin_nontemporal_load((const GAS f32x4*)(src + (size_t)i * N));
    GAS unsigned char* dst = (GAS unsigned char*)(WT + (size_t)(drow0 + 4 * ng) * pitch + k0 + 16 * kq);
#pragma unroll
    for (int c = 0; c < 4; ++c) { u32x4 o;
#pragma unroll
        for (int d = 0; d < 4; ++d) o[d] = I8 ? pack4_i8(x[4 * d][c] * scale, x[4 * d + 1][c] * scale, x[4 * d + 2][c] * scale, x[4 * d + 3][c] * scale) : pack4_fp8(x[4 * d][c] * scale, x[4 * d + 1][c] * scale, x[4 * d + 2][c] * scale, x[4 * d + 3][c] * scale);
        __builtin_nontemporal_store(o, (GAS u32x4*)(dst + (size_t)c * pitch)); }
}
__device__ __forceinline__ void q8_load(const float* W, int N, int k0, int n0, int lane, f32x4 (&x)[16]) {
    const int kq = lane & 7, ng = lane >> 3;
    const GAS float* src = (const GAS float*)(W + (size_t)(k0 + 16 * kq) * N + n0 + 4 * ng);
#pragma unroll
    for (int i = 0; i < 16; ++i) x[i] = __builtin_nontemporal_load((const GAS f32x4*)(src + (size_t)i * N));
}
template <bool I8>
__device__ __forceinline__ void q8_store(const f32x4 (&x)[16], unsigned char* WT, int pitch, int k0, int drow0, float scale, int lane) {
    const int kq = lane & 7, ng = lane >> 3;
    GAS unsigned char* dst = (GAS unsigned char*)(WT + (size_t)(drow0 + 4 * ng) * pitch + k0 + 16 * kq);
#pragma unroll
    for (int c = 0; c < 4; ++c) { u32x4 o;
#pragma unroll
        for (int d = 0; d < 4; ++d) o[d] = I8 ? pack4_i8(x[4 * d][c] * scale, x[4 * d + 1][c] * scale, x[4 * d + 2][c] * scale, x[4 * d + 3][c] * scale) : pack4_fp8(x[4 * d][c] * scale, x[4 * d + 1][c] * scale, x[4 * d + 2][c] * scale, x[4 * d + 3][c] * scale);
        __builtin_nontemporal_store(o, (GAS u32x4*)(dst + (size_t)c * pitch)); }
}
__device__ __forceinline__ int vrow_in(int n) {
    if (n >= 2048 && n < 4096) { const int j = n - 2048; return 2048 + 256 * (j >> 7) + (j & 127); }
    if (n >= 4096 && n < 6144) { const int j = n - 4096; return 2048 + 256 * (j >> 7) + 128 + (j & 127); }
    return n;
}
__device__ __forceinline__ int vrow_gu(int n) { return n < 2048 ? 256 * (n >> 7) + (n & 127) : 256 * ((n - 2048) >> 7) + 128 + (n & 127); }
__device__ __forceinline__ void ln_row_to_bf16(const float* xrow, const float* g, const float* b, bf16_t* orow, unsigned char* qrow, float qscale, int lane) {
    const GAS f32x4* xr = (const GAS f32x4*)xrow + lane;
    f32x4 v[8]; float s = 0.f;
#pragma unroll
    for (int j = 0; j < 8; ++j) { v[j] = __builtin_nontemporal_load(xr + 64 * j); s += (v[j].x + v[j].y) + (v[j].z + v[j].w); }
    const float mean = wave_sum(s) * (1.f / D); float s2 = 0.f;
#pragma unroll
    for (int j = 0; j < 8; ++j) { v[j] = v[j] - mean; s2 += (v[j].x * v[j].x + v[j].y * v[j].y) + (v[j].z * v[j].z + v[j].w * v[j].w); }
    const float rstd = 1.f / sqrtf(wave_sum(s2) * (1.f / D) + LN_EPS);
    GAS u32x2* o8 = (GAS u32x2*)orow + lane;
#pragma unroll
    for (int j = 0; j < 8; ++j) { const f32x4 gg = *((const GAS f32x4*)g + lane + 64 * j), bb = *((const GAS f32x4*)b + lane + 64 * j); const f32x4 y = v[j] * rstd * gg + bb;
        u32x2 w; w.x = cvt_pk_bf16(y.x, y.y); w.y = cvt_pk_bf16(y.z, y.w); o8[64 * j] = w;
        if (qrow) *((GAS unsigned*)qrow + lane + 64 * j) = pack4_i8(y.x * qscale, y.y * qscale, y.z * qscale, y.w * qscale); }
}
constexpr int CV_GU = NE * 16 * 128, CV_D = NE * 16 * 64, CV_TOTAL = CV_GU + CV_D;
__device__ __forceinline__ void conv_item(Frame& F, int r) {
    f32x4 x0[16];
    if (r < CV_GU) { const int e = r / (16 * 128), q = r % (16 * 128), kb = q / 128, nb = q % 128; const float* W = F_w_gate_up + (size_t)e * 2048 * 4096; unsigned char* WT = F_Wgu8 + (size_t)e * 4096 * 2048;
        q8_load(W, 4096, 128 * kb, 32 * nb, F.lane, x0); q8_store<true>(x0, WT, 2048, 128 * kb, vrow_gu(32 * nb), QS(3 + e), F.lane); }
    else { r -= CV_GU; const int e = r / (16 * 64), q = r % (16 * 64), kb = q / 64, nb = q % 64; const float* W = F_w_down + (size_t)e * 2048 * 2048; unsigned char* WT = F_Wd8 + (size_t)e * 2048 * 2048;
        q8_load(W, 2048, 128 * kb, 32 * nb, F.lane, x0); q8_store<false>(x0, WT, 2048, 128 * kb, 32 * nb, W_SCALE_D, F.lane); }
}
__device__ __forceinline__ void conv_pair(Frame& F, int r) {
    f32x4 x0[16], x1[16];
    if (r < CV_GU) { const int e = r / (16 * 128), q = r % (16 * 128), kb = q / 128, nb = q % 128; const float* W = F_w_gate_up + (size_t)e * 2048 * 4096; unsigned char* WT = F_Wgu8 + (size_t)e * 4096 * 2048;
        q8_load(W, 4096, 128 * kb, 32 * nb, F.lane, x0); q8_load(W, 4096, 128 * kb, 32 * nb + 32, F.lane, x1);
        q8_store<true>(x0, WT, 2048, 128 * kb, vrow_gu(32 * nb), QS(3 + e), F.lane); q8_store<true>(x1, WT, 2048, 128 * kb, vrow_gu(32 * nb + 32), QS(3 + e), F.lane); }
    else { r -= CV_GU; const int e = r / (16 * 64), q = r % (16 * 64), kb = q / 64, nb = q % 64; const float* W = F_w_down + (size_t)e * 2048 * 2048; unsigned char* WT = F_Wd8 + (size_t)e * 2048 * 2048;
        q8_load(W, 2048, 128 * kb, 32 * nb, F.lane, x0); q8_load(W, 2048, 128 * kb, 32 * nb + 32, F.lane, x1);
        q8_store<false>(x0, WT, 2048, 128 * kb, 32 * nb, W_SCALE_D, F.lane); q8_store<false>(x1, WT, 2048, 128 * kb, 32 * nb + 32, W_SCALE_D, F.lane); }
}
constexpr int CV_NQ = 8, CV_QL = CV_TOTAL / CV_NQ;
__device__ __forceinline__ int conv_grab(Frame& F, int& q, int cbase = CW_CONV) {
    for (int tries = 0; tries < CV_NQ; ++tries) {
        int v = 0; if (F.lane == 0) v = (int)__hip_atomic_fetch_add(F.ctl + cbase + 32 * q, (unsigned)MK_CONV_N, RLX_AGENT);
        v = __builtin_amdgcn_readfirstlane(v);
        if (MK_CONVWRAP && cbase != CW_CONV) return q * CV_QL + (int)((unsigned)v % (unsigned)CV_QL);
        if (v < CV_QL) return q * CV_QL + v;
        q = (q + 1) & (CV_NQ - 1);
    }
    return -1;
}
__device__ __forceinline__ void conv_worker(Frame& F, int gd_word, int n_gemm, int cbase = CW_CONV) {
    if (gd_word >= 0) { int g = 0; if (F.lane == 0) g = (int)__hip_atomic_load(F.ctl + gd_word, RLX_AGENT); if (__builtin_amdgcn_readfirstlane(g) >= n_gemm) return; }
    int q = (int)(xb_xcc_id() & (CV_NQ - 1));
    int cur = conv_grab(F, q, cbase);
    bool stop = false;
    while (cur >= 0) {
        int nx = 0, g = 0;
        if (!stop && F.lane == 0) { nx = (int)__hip_atomic_fetch_add(F.ctl + cbase + 32 * q, (unsigned)MK_CONV_N, RLX_AGENT); if (gd_word >= 0) g = (int)__hip_atomic_load(F.ctl + gd_word, RLX_AGENT); }
        if (MK_CONV_N == 2) conv_pair(F, cur); else conv_item(F, cur);
        if (stop) break;
        nx = __builtin_amdgcn_readfirstlane(nx); g = __builtin_amdgcn_readfirstlane(g);
        if (gd_word >= 0 && g >= n_gemm) stop = true;
        if (MK_CONVWRAP && cbase != CW_CONV) nx = (int)((unsigned)nx % (unsigned)CV_QL);
        if (nx < CV_QL) cur = q * CV_QL + nx;
        else if (stop) break;
        else { q = (q + 1) & (CV_NQ - 1); cur = conv_grab(F, q, cbase); }
    }
}
__device__ __forceinline__ void conv_cleanup(Frame& F) {
    int c = CV_QL; if (F.lane < CV_NQ) c = (int)__hip_atomic_load(F.ctl + CW_CONV + 32 * F.lane, RLX_AGENT);
    c = c < CV_QL ? c : CV_QL;
    const int rem = CV_QL - c;
    int incl = rem;
#pragma unroll
    for (int d = 1; d < CV_NQ; d <<= 1) { const int o = __shfl_up(incl, d); if (F.lane >= d) incl += o; }
    const int total = __builtin_amdgcn_readlane(incl, CV_NQ - 1);
    const int first = F.lane * CV_QL + c - (incl - rem);
    const int gw = F.bx * NWAVES + F.wave, NGW = F.G * NWAVES;
    for (int i = MK_CONV_N * gw; i < total; i += MK_CONV_N * NGW) {
        const int qi = __builtin_popcountll(__ballot(F.lane < CV_NQ && incl <= i));
        const int it = __builtin_amdgcn_readlane(first, qi) + i;
        if (MK_CONV_N == 2) conv_pair(F, it); else conv_item(F, it);
    }
}
__device__ __forceinline__ void gemm_done(Frame& F, int gd_word) { if (F.tid == 0) (void)__hip_atomic_fetch_add(F.ctl + gd_word, 1u, RLX_AGENT); }
__device__ __forceinline__ void p0_prologue(Frame& F) {
    const int gw = F.bx * NWAVES + F.wave, NGW = F.G * NWAVES;
    constexpr int I_IN = 32 * (7168 / 32), I_G8 = 16 * (DIN / 32), I_A = 16 * 64, I_O = 16 * 64, I_P = 4 * 2 * 16;
    constexpr int NITEMS = I_IN + I_G8 + I_A + I_O + I_P;
    for (int it = gw; it < NITEMS; it += NGW) {
        int r = it;
        if (r < I_IN) { const int kb = r / (7168 / 32), nb = r % (7168 / 32); if (!MK_ALL_FP8) transpose_item(F_w_in, DIN, F_Win_t, 2048, 64 * kb, 32 * nb, vrow_in(32 * nb), F.lane); continue; } r -= I_IN;
        if (r < I_G8) { const int kb = r / (DIN / 32), nb = r % (DIN / 32), n0 = 32 * nb; if (MK_ALL_FP8 || (n0 >= 2048 && n0 < 6144) || n0 >= 7168) transpose_item_q8<true>(F_w_in, DIN, F_Win8, 2048, 128 * kb, n0, vrow_in(n0), QS(2), F.lane); continue; } r -= I_G8;
        if (r < I_A) { const int kb = r / 64, nb = r % 64; transpose_item_q8<false>(F_w_a_out, 2048, F_Wa8, 2048, 128 * kb, 32 * nb, 32 * nb, P3_WA_SCALE, F.lane); continue; } r -= I_A;
        if (r < I_O) { const int kb = r / 64, nb = r % 64; transpose_item_q8<false>(F_w_o, 2048, F_Wo8, 2048, 128 * kb, 32 * nb, 32 * nb, P4_WO_SCALE, F.lane); continue; } r -= I_O;
        { const int g = r / 32, q = r % 32, kb = q / 16, nb = q % 16; transpose_item_q8<false>(F_pool_w + (size_t)g * 256 * 512, 512, F_Wp8, 2048, 128 * kb, 32 * nb, g * 512 + 32 * nb, P3_WP_SCALE, F.lane); }
    }
    for (int idx = F.bx * NTHREADS + F.tid; idx < 32 * 2048; idx += F.G * NTHREADS) { const int n = idx >> 11, k = idx & 2047; const float w = F_router_w[(size_t)k * 32 + n];
        const unsigned hi = cvt_pk_bf16(w, 0.f) & 0xffffu; const float rem = w - __uint_as_float(hi << 16); F_RWhi[idx] = (bf16_t)hi; F_RWlo[idx] = (bf16_t)(cvt_pk_bf16(rem, 0.f) & 0xffffu); }
    for (int m = gw; m < T + NMETA; m += NGW) {
        if (m < T) ln_row_to_bf16(F_x + (size_t)m * D, F_ln_in_g, F_ln_in_b, F_H0 + (size_t)m * D, F_H0Q + (size_t)m * D, QS(0), F.lane);
        else ln_row_to_bf16(F_meta + (size_t)(m - T) * D, F_ln_in_g, F_ln_in_b, F_H0meta + (size_t)(m - T) * D, F_H0metaQ + (size_t)(m - T) * D, QS(0), F.lane);
    }
}

__device__ __forceinline__ void p1_meta(Frame& F) {
    const float deq = 1.0f / (QS(0) * QS(2));
    for (int task = F.bx; task < 192; task += F.G) {
    const int fr = F.lane & 15, fq = F.lane >> 4, w = F.wave;
    const bool is_cu = task < 128;
    const int col = is_cu ? 16 * task : 16 * (task - 128);
    const int vr = is_cu ? 2048 + 256 * (col >> 7) + (col & 127) + fr : 6144 + col + fr;
    const unsigned char* a_p = F_H0metaQ + (size_t)fr * 2048 + 16 * fq + 256 * w;
    const unsigned char* b0 = F_Win8 + (size_t)vr * 2048 + 16 * fq + 256 * w; const unsigned char* b1 = b0 + (size_t)128 * 2048;
    i32x4v av[4], x0[4], x1[4];
#pragma unroll
    for (int kk = 0; kk < 4; ++kk) { av[kk] = *(const i32x4v*)(a_p + 64 * kk); x0[kk] = *(const i32x4v*)(b0 + 64 * kk); x1[kk] = is_cu ? *(const i32x4v*)(b1 + 64 * kk) : x0[kk]; }
    i32x4v acc0 = {0, 0, 0, 0}, acc1 = {0, 0, 0, 0};
#pragma unroll
    for (int kk = 0; kk < 4; ++kk) { acc0 = __builtin_amdgcn_mfma_i32_16x16x64_i8(av[kk], x0[kk], acc0, 0, 0, 0); acc1 = __builtin_amdgcn_mfma_i32_16x16x64_i8(av[kk], x1[kk], acc1, 0, 0, 0); }
    LAS i32x4v* part = (LAS i32x4v*)(F.lds + L_STAGE);
    part[(w * 2 + 0) * 64 + F.lane] = acc0; part[(w * 2 + 1) * 64 + F.lane] = acc1;
    __syncthreads();
    if (w == 0) {
        i32x4v s0 = {0, 0, 0, 0}, s1 = {0, 0, 0, 0};
#pragma unroll
        for (int ww = 0; ww < 8; ++ww) { s0 += part[(ww * 2 + 0) * 64 + F.lane]; s1 += part[(ww * 2 + 1) * 64 + F.lane]; }
        if (is_cu) {
#pragma unroll
            for (int i = 0; i < 4; ++i) F_CUmeta[(size_t)(4 * fq + i) * 2048 + col + fr] = (bf16_t)(cvt_pk_bf16((float)s0[i] * (float)s1[i] * (deq * deq), 0.f) & 0xffffu);
        } else {
#pragma unroll
            for (int i = 0; i < 4; ++i) F_Vmeta[(size_t)(4 * fq + i) * 1024 + col + fr] = (bf16_t)(cvt_pk_bf16((float)s0[i] * deq, 0.f) & 0xffffu);
        }
    }
    __syncthreads();
    }
}

__device__ __forceinline__ void p2_elementwise(Frame& F) {
    const int gw = F.bx * NWAVES + F.wave, NGW = F.G * NWAVES, lane = F.lane;
    constexpr int RCH = 32;
    for (int task = gw; task < (T / RCH) * 8; task += NGW) {
        const int sl = task & 7, t0 = (task >> 3) * RCH, s0 = t0 & (SEQ - 1);
        if (sl < 4) {
            const int col = sl * 512 + 8 * lane;
            const bf16_t* cu = F_CU + (size_t)t0 * 2048 + col; const unsigned char* bg = F_BG8 + (size_t)t0 * 2048 + col; unsigned char* ap = F_AP8 + (size_t)t0 * APITCH + col; const float binv = P3_A_SCALE / QS(35);
            const f32x4 w0a = *(const f32x4*)(F_conv_w + col), w0b = *(const f32x4*)(F_conv_w + col + 4), w1a = *(const f32x4*)(F_conv_w + 2048 + col), w1b = *(const f32x4*)(F_conv_w + 2048 + col + 4),
                        w2a = *(const f32x4*)(F_conv_w + 4096 + col), w2b = *(const f32x4*)(F_conv_w + 4096 + col + 4);
            const u32x4 p2 = (s0 > 0) ? *(const u32x4*)(cu - 2 * 2048) : *(const u32x4*)(F_CUmeta + (size_t)14 * 2048 + col);
            const u32x4 p1 = (s0 > 0) ? *(const u32x4*)(cu - 1 * 2048) : *(const u32x4*)(F_CUmeta + (size_t)15 * 2048 + col);
            f32x4 x0a, x0b, x1a, x1b; unpack8(p2, x0a, x0b); unpack8(p1, x1a, x1b);
#pragma unroll 1
            for (int r0 = 0; r0 < RCH; r0 += 8) {
                u32x4 cw[8]; u32x2 bw[8];
#pragma unroll
                for (int i = 0; i < 8; ++i) { cw[i] = __builtin_nontemporal_load((const u32x4*)(cu + (size_t)(r0 + i) * 2048)); bw[i] = __builtin_nontemporal_load((const u32x2*)(bg + (size_t)(r0 + i) * 2048)); }
#pragma unroll
                for (int i = 0; i < 8; ++i) { f32x4 x2a, x2b; unpack8(cw[i], x2a, x2b); const f32x4 ba = s8x4_to_f(bw[i].x) * binv, bb = s8x4_to_f(bw[i].y) * binv;
                    const f32x4 ya = ba * (w0a * x0a + w1a * x1a + w2a * x2a), yb = bb * (w0b * x0b + w1b * x1b + w2b * x2b);
                    u32x2 o8; o8.x = pack4_fp8(clamp448(ya[0]), clamp448(ya[1]), clamp448(ya[2]), clamp448(ya[3])); o8.y = pack4_fp8(clamp448(yb[0]), clamp448(yb[1]), clamp448(yb[2]), clamp448(yb[3]));
                    *(u32x2*)(ap + (size_t)(r0 + i) * APITCH) = o8;
                    x0a = x1a; x0b = x1b; x1a = x2a; x1b = x2b; }
            }
        } else {
            const int g = sl - 4, win = 2 << g, col = g * 256 + 4 * lane; const float inv = 1.0f / (float)win;
            const bf16_t* vp = F_V + (size_t)t0 * 1024 + col; const bf16_t* vm = F_Vmeta + (size_t)16 * 1024 + col; unsigned char* ap = F_AP8 + (size_t)t0 * APITCH + 2048 + col;
#define VROW(q) ((s0 + (q) >= 0) ? *(const u32x2*)(vp + (ptrdiff_t)(q) * 1024) : *(const u32x2*)(vm + (ptrdiff_t)(s0 + (q)) * 1024))
            f32x4 sum = {0.f, 0.f, 0.f, 0.f};
            for (int i = 1; i < win; ++i) { const u32x2 w = VROW(-i); sum += (f32x4){bf_lo(w.x), bf_hi(w.x), bf_lo(w.y), bf_hi(w.y)}; }
#pragma unroll 1
            for (int r0 = 0; r0 < RCH; r0 += 8) {
                u32x2 nw[8], ow[8];
#pragma unroll
                for (int i = 0; i < 8; ++i) { nw[i] = *(const u32x2*)(vp + (size_t)(r0 + i) * 1024); ow[i] = VROW(r0 + i - win + 1); }
#pragma unroll
                for (int i = 0; i < 8; ++i) { const f32x4 v = {bf_lo(nw[i].x), bf_hi(nw[i].x), bf_lo(nw[i].y), bf_hi(nw[i].y)}, o = {bf_lo(ow[i].x), bf_hi(ow[i].x), bf_lo(ow[i].y), bf_hi(ow[i].y)};
                    sum += v; const f32x4 p = (sum * inv - v) * P3_A_SCALE; sum -= o;
                    *(unsigned*)(ap + (size_t)(r0 + i) * APITCH) = pack4_fp8(clamp448(p.x), clamp448(p.y), clamp448(p.z), clamp448(p.w)); }
            }
#undef VROW
        }
    }
}

__device__ __forceinline__ void p5_router(Frame& F) {
    LAS unsigned char* lds = F.lds;
    LAS int* sel_e = (LAS int*)(lds + L_SEL_E); LAS int* sel_r = (LAS int*)(lds + L_SEL_R); LAS float* sel_w = (LAS float*)(lds + L_SEL_W);
    LAS int* hist = (LAS int*)(lds + L_HIST); LAS int* gbase = (LAS int*)(lds + L_BASE);
    LAS float* part = (LAS float*)(lds + L_PART);
    const int lane = F.lane, w = F.wave, fr = lane & 15, fq = lane >> 4;
    const float qs1 = QS(1);
    for (int blk = F.bx; blk < T / 64; blk += F.G) {
        if (F.tid < 32) hist[F.tid] = 0;
        __syncthreads();
        u32x2 hc[2][8], mc[2][8];
#pragma unroll
        for (int q = 0; q < 2; ++q) { const size_t t = (size_t)blk * 64 + 2 * w + q; const GAS u32x2* hr = (const GAS u32x2*)(F_H0 + t * D) + lane; const GAS u32x2* mr = (const GAS u32x2*)(F_MIX + t * D) + lane;
#pragma unroll
            for (int j = 0; j < 8; ++j) { hc[q][j] = __builtin_nontemporal_load(hr + 64 * j); mc[q][j] = __builtin_nontemporal_load(mr + 64 * j); } }
#pragma unroll 1
        for (int p = 0; p < 4; ++p) {
#pragma unroll
            for (int q = 0; q < 2; ++q) {
                const int tl = 2 * w + q; const size_t t = (size_t)blk * 64 + 16 * p + tl;
                f32x4 v[8]; float s = 0.f;
#pragma unroll
                for (int j = 0; j < 8; ++j) { const u32x2 hw = hc[q][j], mw = mc[q][j];
                    v[j] = (f32x4){bf_lo(hw.x), bf_hi(hw.x), bf_lo(hw.y), bf_hi(hw.y)} * DN_ALPHA + (f32x4){bf_lo(mw.x), bf_hi(mw.x), bf_lo(mw.y), bf_hi(mw.y)}; s += (v[j].x + v[j].y) + (v[j].z + v[j].w); }
                const float mean = wave_sum(s) * (1.f / D); float s2 = 0.f;
#pragma unroll
                for (int j = 0; j < 8; ++j) { v[j] = v[j] - mean; s2 += (v[j].x * v[j].x + v[j].y * v[j].y) + (v[j].z * v[j].z + v[j].w * v[j].w); }
                const float rstd = 1.f / sqrtf(wave_sum(s2) * (1.f / D) + LN_EPS);
                GAS u32x2* o8 = (GAS u32x2*)(F_H1 + t * D) + lane;
#pragma unroll
                for (int j = 0; j < 8; ++j) { const f32x4 gg = *((const GAS f32x4*)F_ln1_g + lane + 64 * j), bb = *((const GAS f32x4*)F_ln1_b + lane + 64 * j); const f32x4 y = v[j] * rstd * gg + bb;
                    u32x2 hi; hi.x = cvt_pk_bf16(y.x, y.y); hi.y = cvt_pk_bf16(y.z, y.w); o8[64 * j] = hi;
                    *((GAS unsigned*)(F_H1Q + t * D) + lane + 64 * j) = pack4_i8(y.x * qs1, y.y * qs1, y.z * qs1, y.w * qs1);
                    const f32x4 rem = {y.x - bf_lo(hi.x), y.y - bf_hi(hi.x), y.z - bf_lo(hi.y), y.w - bf_hi(hi.y)};
                    u32x2 lo; lo.x = cvt_pk_bf16(rem.x, rem.y); lo.y = cvt_pk_bf16(rem.z, rem.w);
                    const int boff = tl * RPITCH + (4 * lane + 256 * j) * 2;
                    *(LAS u32x2*)(lds + L_AHI + boff) = hi; *(LAS u32x2*)(lds + L_ALO + boff) = lo; }
            }
            __syncthreads();
            f32x4 acc[2] = {{0.f, 0.f, 0.f, 0.f}, {0.f, 0.f, 0.f, 0.f}};
#pragma unroll 2
            for (int ks = 0; ks < 8; ++ks) { const int k0 = 256 * w + 32 * ks + 8 * fq;
                const bf16x8 ah = *(const LAS bf16x8*)(lds + L_AHI + fr * RPITCH + k0 * 2), al = *(const LAS bf16x8*)(lds + L_ALO + fr * RPITCH + k0 * 2);
#pragma unroll
                for (int nb = 0; nb < 2; ++nb) { const bf16x8 bh = *(const bf16x8*)(F_RWhi + (size_t)(16 * nb + fr) * 2048 + k0), bl = *(const bf16x8*)(F_RWlo + (size_t)(16 * nb + fr) * 2048 + k0);
                    acc[nb] = __builtin_amdgcn_mfma_f32_16x16x32_bf16(ah, bh, acc[nb], 0, 0, 0);
                    acc[nb] = __builtin_amdgcn_mfma_f32_16x16x32_bf16(al, bh, acc[nb], 0, 0, 0);
                    acc[nb] = __builtin_amdgcn_mfma_f32_16x16x32_bf16(ah, bl, acc[nb], 0, 0, 0); } }
            if (p < 3) {
#pragma unroll
                for (int q = 0; q < 2; ++q) { const size_t t = (size_t)blk * 64 + 16 * (p + 1) + 2 * w + q; const GAS u32x2* hr = (const GAS u32x2*)(F_H0 + t * D) + lane; const GAS u32x2* mr = (const GAS u32x2*)(F_MIX + t * D) + lane;
#pragma unroll
                    for (int j = 0; j < 8; ++j) { hc[q][j] = __builtin_nontemporal_load(hr + 64 * j); mc[q][j] = __builtin_nontemporal_load(mr + 64 * j); } } }
#pragma unroll
            for (int nb = 0; nb < 2; ++nb)
#pragma unroll
                for (int i = 0; i < 4; ++i) part[(w * 16 + 4 * fq + i) * 32 + 16 * nb + fr] = acc[nb][i];
            __syncthreads();
            { const int tk = F.tid >> 5, e = F.tid & 31; float x = F_router_b[e];
#pragma unroll
              for (int ww = 0; ww < 8; ++ww) x += part[(ww * 16 + tk) * 32 + e];
              float vals[4]; int idxs[4]; float cur = x;
#pragma unroll
              for (int r = 0; r < 4; ++r) { float bv = cur; int bi = e;
#pragma unroll
                  for (int o = 16; o >= 1; o >>= 1) { const float ov = __shfl_xor(bv, o); const int oi = __shfl_xor(bi, o); if (ov > bv || (ov == bv && oi < bi)) { bv = ov; bi = oi; } }
                  vals[r] = bv; idxs[r] = bi; if (e == bi) cur = -3.0e38f; }
              const float e1 = __expf(vals[1] - vals[0]), e2 = __expf(vals[2] - vals[0]), e3 = __expf(vals[3] - vals[0]); const float inv = 1.0f / (1.0f + e1 + e2 + e3);
              if (e < 4) { const int se = e == 0 ? idxs[0] : e == 1 ? idxs[1] : e == 2 ? idxs[2] : idxs[3]; const float sw = (e == 0 ? 1.0f : e == 1 ? e1 : e == 2 ? e2 : e3) * inv;
                  const int rk = __hip_atomic_fetch_add(hist + se, 1, __ATOMIC_RELAXED, __HIP_MEMORY_SCOPE_WORKGROUP); const int slot = (16 * p + tk) * 4 + e; sel_e[slot] = se; sel_r[slot] = rk; sel_w[slot] = sw; } }
            __syncthreads();
        }
        if (F.tid < 32) gbase[F.tid] = (int)__hip_atomic_fetch_add(F.ctl + CW_CNT + F.tid, (unsigned)hist[F.tid], RLX_AGENT);
        __syncthreads();
        if (F.tid < 256) { const int se = sel_e[F.tid], pos = gbase[se] + sel_r[F.tid]; const int tok = blk * 64 + (F.tid >> 2);
            F_tok_list[(size_t)se * T + pos] = tok; F_wt_list[(size_t)se * T + pos] = sel_w[F.tid]; F_topk_slot[(size_t)tok * 4 + (F.tid & 3)] = se * T + pos; }
        __syncthreads();
    }
}

__device__ __forceinline__ void p8_final(Frame& F) {
    const LAS int* tbase = (const LAS int*)(F.lds + L_TBASE);
    const int gw = F.bx * NWAVES + F.wave, NGW = F.G * NWAVES, lane = F.lane;
    for (int t = gw; t < T; t += NGW) {
        size_t rows[4];
#pragma unroll
        for (int k = 0; k < 4; ++k) { const int sl = F_topk_slot[(size_t)t * 4 + k]; const int e = sl >> 14, pos = sl & (T - 1); rows[k] = (size_t)tbase[e] * 256 + pos; }
        f32x4 v[8]; float s = 0.f;
#pragma unroll
        for (int j = 0; j < 8; ++j) { const u32x2 hw = __builtin_nontemporal_load((const GAS u32x2*)(F_H1 + (size_t)t * D) + lane + 64 * j);
            f32x4 a = (f32x4){bf_lo(hw.x), bf_hi(hw.x), bf_lo(hw.y), bf_hi(hw.y)} * DN_ALPHA;
#pragma unroll
            for (int k = 0; k < 4; ++k) { const int ow = __builtin_nontemporal_load((const GAS int*)(F_OSLOT8 + rows[k] * D) + lane + 64 * j); const f32x2 lo = __builtin_amdgcn_cvt_pk_f32_fp8(ow, false), hi = __builtin_amdgcn_cvt_pk_f32_fp8(ow, true);
                a += (f32x4){lo.x, lo.y, hi.x, hi.y} * (1.0f / OS_SCALE); }
            v[j] = a; s += (a.x + a.y) + (a.z + a.w); }
        const float mean = wave_sum(s) * (1.f / D); float s2 = 0.f;
#pragma unroll
        for (int j = 0; j < 8; ++j) { v[j] = v[j] - mean; s2 += (v[j].x * v[j].x + v[j].y * v[j].y) + (v[j].z * v[j].z + v[j].w * v[j].w); }
        const float rstd = 1.f / sqrtf(wave_sum(s2) * (1.f / D) + LN_EPS);
        GAS f32x4* op = (GAS f32x4*)(F_out + (size_t)t * D) + lane;
#pragma unroll
        for (int j = 0; j < 8; ++j) { const f32x4 gg = *((const GAS f32x4*)F_ln2_g + lane + 64 * j), bb = *((const GAS f32x4*)F_ln2_b + lane + 64 * j); __builtin_nontemporal_store(v[j] * rstd * gg + bb, op + 64 * j); }
    }
}

__global__ void __launch_bounds__(NTHREADS, 2) mk_fwd(Args args) {
    extern __shared__ __attribute__((aligned(16))) unsigned char lds_raw[];
    Frame F;
    F.lds = (LAS unsigned char*)lds_raw;
    F.tid = threadIdx.x; F.lane = F.tid & 63; F.wave = __builtin_amdgcn_readfirstlane(F.tid >> 6); F.G = gridDim.x; F.bx = blockIdx.x;
    F.ws = args.ws; F.a = &args;
    F.ctl = (unsigned*)(F.ws + WS_CTL);
    volatile LAS unsigned* MISC = (volatile LAS unsigned*)(F.lds + L_MISC);
    if (F.tid < 32) MISC[F.tid] = 0u;
    { LAS float* part = (LAS float*)(F.lds + L_STAGE);
      const int so = F.wave * 64 + F.lane;
      f32x4 gv[2], bv[2], wv[33];
      gv[0] = *((const GAS f32x4*)F_ln_in_g + so); bv[0] = *((const GAS f32x4*)F_ln_in_b + so); gv[1] = *((const GAS f32x4*)F_ln1_g + so); bv[1] = *((const GAS f32x4*)F_ln1_b + so);
      wv[0] = *((const GAS f32x4*)F_w_in + so);
#pragma unroll
      for (int e = 0; e < 32; ++e) wv[1 + e] = *((const GAS f32x4*)(F_w_gate_up + (size_t)e * 2048 * 4096) + so);
#pragma unroll
      for (int q = 0; q < 2; ++q) { const float gm = wave_max(fmaxf(fmaxf(fabsf(gv[q].x), fabsf(gv[q].y)), fmaxf(fabsf(gv[q].z), fabsf(gv[q].w)))), bm = wave_max(fmaxf(fmaxf(fabsf(bv[q].x), fabsf(bv[q].y)), fmaxf(fabsf(bv[q].z), fabsf(bv[q].w))));
          if (F.lane == 0) { part[F.wave * 37 + 2 * q] = gm; part[F.wave * 37 + 2 * q + 1] = bm; } }
#pragma unroll
      for (int i = 0; i < 33; ++i) { const float ss = wave_sum((wv[i].x * wv[i].x + wv[i].y * wv[i].y) + (wv[i].z * wv[i].z + wv[i].w * wv[i].w)); if (F.lane == 0) part[F.wave * 37 + 4 + i] = ss; }
      __syncthreads();
      LAS float* qs = (LAS float*)(F.lds + L_QS);
      if (F.tid < 2) { float gm = 0.f, bm = 0.f;
#pragma unroll
          for (int w8 = 0; w8 < 8; ++w8) { gm = fmaxf(gm, part[w8 * 37 + 2 * F.tid]); bm = fmaxf(bm, part[w8 * 37 + 2 * F.tid + 1]); }
          qs[F.tid] = 127.0f / (Q_ACT_SIGMAS * gm + bm + 1e-20f); }
      else if (F.tid == 35) { float gm = 0.f, bm = 0.f, ss = 0.f;
#pragma unroll
          for (int w8 = 0; w8 < 8; ++w8) { gm = fmaxf(gm, part[w8 * 37 + 0]); bm = fmaxf(bm, part[w8 * 37 + 1]); ss += part[w8 * 37 + 4]; }
          qs[35] = 127.0f / (6.0f * 45.254834f * sqrtf(ss * (1.0f / 2048.0f)) * (gm + bm) + 1e-30f); }
      else if (F.tid < 35) { float ss = 0.f;
#pragma unroll
          for (int w8 = 0; w8 < 8; ++w8) ss += part[w8 * 37 + 4 + (F.tid - 2)];
          qs[F.tid] = 127.0f / (Q_W_SIGMAS * sqrtf(ss * (1.0f / 2048.0f)) + 1e-30f); } }
    __syncthreads();
    const int lo = args.ph_lo, hi = args.ph_hi;
    XcdBarrier bar; bar.bar = (unsigned*)(F.ctl + CW_BAR); bar.x = 0; bar.st = nullptr;
    if (hi - lo > 1) bar = xcd_barrier_post((unsigned*)(F.ctl + CW_BAR), MISC + 8);
#ifndef MK_PHMASK
#define MK_PHMASK 0x1ff
#endif
#ifndef MK_REP_MASK
#define MK_REP_MASK 0
#endif
#define IN(k) (((MK_PHMASK >> (k)) & 1) && lo <= (k) && (k) < hi)
#define SEAM(k) do { if (IN(k) && IN((k) + 1)) xcd_barrier(bar); } while (0)

#if MK_CONVPROBE > 0
    if (lo == 0) { if (F.bx >= 256 - MK_CONVPROBE) conv_worker(F, -1, 0, CW_CONV + 512); if (hi - lo > 1) xcd_barrier(bar); }
#endif
    if (IN(0)) { p0_prologue(F); } SEAM(0);
    const bool split = (F.G == 256);
    if (IN(1)) { constexpr int GG = MK_GG1; const int gg = split ? GG : F.G;
        if (F.bx < gg) { p1_meta(F);
            ProbInProj8 Q; Q.G = gg; Q.c = F.bx; Q.A8 = F_H0Q; Q.B8 = F_Win8; Q.BG8 = F_BG8; Q.CU = F_CU; Q.V = F_V; Q.G8 = F_G8; Q.deq = 1.0f / (QS(0) * QS(2)); Q.bgq = QS(35);
            pg8::gemm_phase(F.lds + L_STAGE, Q); gemm_done(F, CW_GDONE + 32 * 1); }
        if (MK_CONVMASK & 2) conv_worker(F, CW_GDONE + 32 * 1, gg, MK_CONVWRAP ? CW_CONV + 512 : CW_CONV); } SEAM(1);
    if (IN(2)) { p2_elementwise(F); } SEAM(2);
    if (IN(3)) { constexpr int GG = MK_GG3; const int gg = split ? GG : F.G;
        if (F.bx < gg) { ProbMix P; P.G = gg; P.c = F.bx; P.AP = F_AP8; P.Wp_t = F_Wp8; P.Wa_t = F_Wa8; P.G8 = F_G8; P.pool_scale = F_pool_scale; P.YB = F_YB; P.MERGED = F_MERGED8;
            pg8::gemm_phase(F.lds + L_STAGE, P); gemm_done(F, CW_GDONE + 32 * 3); }
        if (MK_CONVMASK & 8) conv_worker(F, CW_GDONE + 32 * 3, gg, MK_CONVWRAP ? CW_CONV + 512 : CW_CONV); } SEAM(3);
    if (IN(4)) { constexpr int GG = MK_GG4; const int gg = split ? GG : F.G;
        if (F.bx < gg) { ProbWo P; P.G = gg; P.c = F.bx; P.A = F_MERGED8; P.Bt = F_Wo8; P.MIX = F_MIX;
            pg8::gemm_phase(F.lds + L_STAGE, P); gemm_done(F, CW_GDONE + 32 * 4); }
        if (MK_CONVMASK & 16) conv_worker(F, CW_GDONE + 32 * 4, gg, MK_CONVWRAP ? CW_CONV + 512 : CW_CONV); } SEAM(4);
    if (IN(5)) { conv_cleanup(F); p5_router(F); } SEAM(5);
    int NT6 = -1;
    if (IN(6)) {
        const int NT = moe_build_tables(F); NT6 = NT;
        ProbGateUp P; P.G = F.G; P.c = F.bx; P.NT = NT; P.lds = F.lds; P.H1Q = F_H1Q; P.Wgu8 = F_Wgu8; P.b_gate_up = F_b_gate_up; P.ACT8 = F_ACT8;
        { LAS int* rows = (LAS int*)(F.lds + L_ROWS); const LAS int* cntl = (const LAS int*)(F.lds + L_CNT); const LAS int* tbase = (const LAS int*)(F.lds + L_TBASE);
          ProbGateUp::U u;
          for (int i = 0; i < 18 && P.next(i, u); ++i) { if (F.tid < 256) { const int idx = (u.rt - tbase[u.e]) * 256 + F.tid; rows[i * 256 + F.tid] = idx < cntl[u.e] ? F_tok_list[(size_t)u.e * T + idx] : 0; } }
          VM_WAIT(); __syncthreads(); }
        pg8::gemm_phase(F.lds + L_STAGE, P); } SEAM(6);
    if (IN(7)) {
        const int NT = NT6 >= 0 ? NT6 : moe_build_tables(F);
        ProbDown P; P.G = F.G; P.c = F.bx; P.NT = NT; P.lds = F.lds; P.ACT8 = F_ACT8; P.Wd8 = F_Wd8; P.b_down = F_b_down; P.wt_list = F_wt_list; P.OSLOT8 = F_OSLOT8;
        pg8::gemm_phase(F.lds + L_STAGE, P); } SEAM(7);
    if (IN(8)) { if (NT6 < 0) (void)moe_build_tables(F); p8_final(F); }
#undef IN
#undef SEAM
}

extern "C" void kernel_launch(void* const* d_in, const int* in_sizes, int n_in, void* d_out, int out_size, void* d_ws, size_t ws_size, hipStream_t stream) {
    static int grid = 0;
    if (grid == 0) {
        if (n_in != 20 || in_sizes[0] != T * D || out_size != T * D || ws_size < WS_END) { fprintf(stderr, "kernel_launch: unexpected shapes (n_in %d, in0 %d, out %d, ws %zu); nothing launched\n", n_in, n_in > 0 ? in_sizes[0] : -1, out_size, ws_size); grid = -1; return; }
        int dev = 0, cus = 0, per_cu = 0;
        if (hipGetDevice(&dev) != hipSuccess || hipDeviceGetAttribute(&cus, hipDeviceAttributeMultiprocessorCount, dev) != hipSuccess) { fprintf(stderr, "kernel_launch: device query failed\n"); grid = -1; return; }
        if (hipFuncSetAttribute((const void*)mk_fwd, hipFuncAttributeMaxDynamicSharedMemorySize, LDS_BYTES) != hipSuccess) { fprintf(stderr, "kernel_launch: hipFuncSetAttribute failed\n"); grid = -1; return; }
        if (hipOccupancyMaxActiveBlocksPerMultiprocessor(&per_cu, (const void*)mk_fwd, NTHREADS, LDS_BYTES) != hipSuccess || per_cu < 1) fprintf(stderr, "kernel_launch: note: occupancy query reports %d workgroups per CU\n", per_cu);
        (void)hipGetLastError();
        grid = cus;
    }
    if (grid < 0) return;
    if (hipMemsetAsync((char*)d_ws + WS_CTL, 0, CTL_ZERO_BYTES, stream) != hipSuccess) { fprintf(stderr, "kernel_launch: memset failed\n"); return; }
    Args a{};
    for (int i = 0; i < 20; ++i) a.in[i] = (const float*)d_in[i];
    a.out = (float*)d_out; a.ws = (unsigned char*)d_ws;
#if MK_N_LAUNCHES == 1
    a.ph_lo = 0; a.ph_hi = NPHASE;
    hipLaunchKernelGGL(mk_fwd, dim3(grid), dim3(NTHREADS), LDS_BYTES, stream, a);
#else
    for (int p = 0; p < NPHASE; ++p) { a.ph_lo = p; a.ph_hi = p + 1; const int reps = ((MK_REP_MASK >> p) & 1) ? 2 : 1;
        for (int r = 0; r < reps; ++r) { if (r > 0 && p == 5) (void)hipMemsetAsync((char*)d_ws + WS_CTL + CW_CNT * 4, 0, 128, stream);
            hipLaunchKernelGGL(mk_fwd, dim3(grid), dim3(NTHREADS), LDS_BYTES, stream, a); } }
#endif
    const hipError_t le = hipPeekAtLastError();
    if (le != hipSuccess) fprintf(stderr, "kernel_launch: launch failed: %s\n", hipGetErrorName(le));
}
```
